# Optimizing an MI355X kernel written in HIP

```python
import math
import jax
import jax.numpy as jnp
from jax import lax
import numpy as np

D_MODEL = 1024
BATCH = 8
SEQ = 4096
DEPTH = 2

GRID_W = 64
CTX_LEN = 256
N_EVEN = (DEPTH + 1) // 2
N_ODD = DEPTH // 2
N_MOD = 9
EPS = 1e-6
D_FF = 256 * math.ceil(8 * D_MODEL / 3 / 256)

HEAD_DIM = 64
ATTN_WIDTH = D_MODEL // 2
N_Q_HEADS = ATTN_WIDTH // HEAD_DIM
N_KV_HEADS = max(1, N_Q_HEADS // 4)
KV_GROUP = N_Q_HEADS // N_KV_HEADS
Q_WIDTH = N_Q_HEADS * HEAD_DIM
KV_WIDTH = N_KV_HEADS * HEAD_DIM
WINDOW = 128
BLOCK = 128
ROPE_BASE = 10000.0
NEG_INF = -1e30

SSM_WIDTH = D_MODEL - ATTN_WIDTH
SSM_GROUP = 16
SSM_GROUPS = SSM_WIDTH // SSM_GROUP
SSM_STATE = 64
DT_MIN = 1e-3
DT_MAX = 1e-1

IN_WIDTH = Q_WIDTH + 2 * KV_WIDTH + SSM_WIDTH

FOURIER_GROUPS = 4
FOURIER_GROUP_WIDTH = D_MODEL // FOURIER_GROUPS

kernel_name = "hybrid_swa_s5_fnet_macaron_prefix"


def rms_norm(x, gain):
    xf = x.astype(jnp.float32)
    y = xf * lax.rsqrt(jnp.mean(xf * xf, axis=-1, keepdims=True) + EPS)
    return (y * gain.astype(jnp.float32)).astype(x.dtype)


def modulate(h, shift, scale):
    return h * (1.0 + scale) + shift


def ada_mod(cond, w, b):
    m = (jax.nn.silu(cond) @ w + b)[..., None, :]
    return jnp.split(m, N_MOD, axis=-1)


def swiglu(h, w1, w3, w2):
    return (jax.nn.silu(h @ w1) * (h @ w3)) @ w2


def half_ffn(s, gain, mod3, w1, w3, w2):
    shift, scale, gate = mod3
    return s + 0.5 * gate * swiglu(modulate(rms_norm(s, gain), shift, scale), w1, w3, w2)


def axial_rope_tables(rows):
    row = jnp.repeat(jnp.arange(rows, dtype=jnp.float32), GRID_W)
    col = jnp.tile(jnp.arange(GRID_W, dtype=jnp.float32), rows)
    n_freq = HEAD_DIM // 4
    inv_freq = 1.0 / (ROPE_BASE ** (jnp.arange(n_freq, dtype=jnp.float32) / n_freq))
    ang = jnp.concatenate([row[:, None] * inv_freq, col[:, None] * inv_freq], axis=-1)
    return jnp.cos(ang), jnp.sin(ang)


def apply_rope(x, cos, sin):
    x1, x2 = jnp.split(x.astype(jnp.float32), 2, axis=-1)
    c = cos[None, :, None, :]
    s = sin[None, :, None, :]
    return jnp.concatenate([x1 * c - x2 * s, x1 * s + x2 * c], axis=-1).astype(x.dtype)


def project_heads(h, w_in, q_gain, k_gain, with_q):
    b, n = h.shape[:2]
    if with_q:
        q_part, rest = jnp.split(h @ w_in, [Q_WIDTH], axis=-1)
        q = rms_norm(q_part.reshape(b, n, N_Q_HEADS, HEAD_DIM), q_gain)
    else:
        rest = h @ w_in[:, Q_WIDTH:]
        q = None
    k, v, u = jnp.split(rest, [KV_WIDTH, 2 * KV_WIDTH], axis=-1)
    k = rms_norm(k.reshape(b, n, N_KV_HEADS, HEAD_DIM), k_gain)
    v = v.reshape(b, n, N_KV_HEADS, HEAD_DIM)
    u = u.reshape(b, n, SSM_GROUPS, SSM_GROUP)
    return q, k, v, u


def window_attention(q, k, v, kc, vc, sink):
    b, n = q.shape[:2]
    nb = n // BLOCK
    span = BLOCK + 2 * WINDOW
    scale = HEAD_DIM ** -0.5
    qb = q.reshape(b, nb, BLOCK, N_KV_HEADS, KV_GROUP, HEAD_DIM)
    starts = jnp.arange(nb) * BLOCK
    idx = starts[:, None] + jnp.arange(span)[None, :]
    pad = ((0, 0), (WINDOW, WINDOW), (0, 0), (0, 0))
    kb = jnp.take(jnp.pad(k, pad), idx, axis=1)
    vb = jnp.take(jnp.pad(v, pad), idx, axis=1)
    s_win = jnp.einsum('bnqhgd,bnkhd->bnhgqk', qb, kb).astype(jnp.float32) * scale
    s_ctx = jnp.einsum('bnqhgd,bchd->bnhgqc', qb, kc).astype(jnp.float32) * scale
    key_pos = idx - WINDOW
    q_pos = starts[:, None] + jnp.arange(BLOCK)[None, :]
    ok = ((jnp.abs(key_pos[:, None, :] - q_pos[:, :, None]) <= WINDOW)
          & (key_pos[:, None, :] >= 0) & (key_pos[:, None, :] < n))
    s_win = jnp.where(ok[None, :, None, None], s_win, NEG_INF)
    sink_col = jnp.broadcast_to(
        sink.astype(jnp.float32).reshape(1, 1, N_KV_HEADS, KV_GROUP, 1, 1), s_win.shape[:-1] + (1,))
    p = jax.nn.softmax(jnp.concatenate([s_win, s_ctx, sink_col], axis=-1), axis=-1)
    n_ctx = kc.shape[1]
    p_win = p[..., :span].astype(v.dtype)
    p_ctx = p[..., span:span + n_ctx].astype(v.dtype)
    o = (jnp.einsum('bnhgqk,bnkhd->bnqhgd', p_win, vb)
         + jnp.einsum('bnhgqc,bchd->bnqhgd', p_ctx, vc))
    return o.reshape(b, n, Q_WIDTH)


def context_attention(qc, kc, vc, sink):
    b, n = qc.shape[:2]
    qg = qc.reshape(b, n, N_KV_HEADS, KV_GROUP, HEAD_DIM)
    s = jnp.einsum('bqhgd,bkhd->bhgqk', qg, kc).astype(jnp.float32) * (HEAD_DIM ** -0.5)
    sink_col = jnp.broadcast_to(
        sink.astype(jnp.float32).reshape(1, N_KV_HEADS, KV_GROUP, 1, 1), s.shape[:-1] + (1,))
    p = jax.nn.softmax(jnp.concatenate([s, sink_col], axis=-1), axis=-1)[..., :-1]
    o = jnp.einsum('bhgqk,bkhd->bqhgd', p.astype(vc.dtype), vc)
    return o.reshape(b, n, Q_WIDTH)


def s5_discretize(lam_re, lam_im, log_dt, b_re, b_im):
    dt = jnp.exp(log_dt.astype(jnp.float32))[:, None]
    lr = lam_re.astype(jnp.float32)
    li = lam_im.astype(jnp.float32)
    mag = jnp.exp(lr * dt)
    ar = mag * jnp.cos(li * dt)
    ai = mag * jnp.sin(li * dt)
    nr = ar - 1.0
    den = lr * lr + li * li
    fr = (nr * lr + ai * li) / den
    fi = (ai * lr - nr * li) / den
    br = b_re.astype(jnp.float32)
    bi = b_im.astype(jnp.float32)
    bbr = fr[..., None] * br - fi[..., None] * bi
    bbi = fr[..., None] * bi + fi[..., None] * br
    return ar, ai, bbr, bbi


def s5_combine(e1, e2):
    a1r, a1i, b1r, b1i = e1
    a2r, a2i, b2r, b2i = e2
    return (a1r * a2r - a1i * a2i,
            a1r * a2i + a1i * a2r,
            a2r * b1r - a2i * b1i + b2r,
            a2r * b1i + a2i * b1r + b2i)


def s5_direction(u, uc, lam_re, lam_im, log_dt, b_re, b_im, c_re, c_im, reverse, want_ctx):
    ar, ai, bbr, bbi = s5_discretize(lam_re, lam_im, log_dt, b_re, b_im)
    cr = c_re.astype(jnp.float32)
    ci = c_im.astype(jnp.float32)

    def drive(x):
        xf = x.astype(jnp.float32)
        return (jnp.einsum('bngi,gpi->bngp', xf, bbr), jnp.einsum('bngi,gpi->bngp', xf, bbi))

    def scan(xr, xi):
        n = xr.shape[1]
        a_r = jnp.broadcast_to(ar[None, None], (1, n) + ar.shape)
        a_i = jnp.broadcast_to(ai[None, None], (1, n) + ai.shape)
        _, _, hr, hi = lax.associative_scan(s5_combine, (a_r, a_i, xr, xi), reverse=reverse, axis=1)
        return hr, hi

    def readout(hr, hi):
        return jnp.einsum('gjp,bngp->bngj', cr, hr) - jnp.einsum('gjp,bngp->bngj', ci, hi)

    hcr, hci = scan(*drive(uc))
    end = 0 if reverse else -1
    h0r, h0i = hcr[:, end], hci[:, end]
    xr, xi = drive(u)
    first = -1 if reverse else 0
    xr = xr.at[:, first].add(ar * h0r - ai * h0i)
    xi = xi.at[:, first].add(ar * h0i + ai * h0r)
    hr, hi = scan(xr, xi)
    y = readout(hr, hi)
    yc = readout(hcr, hci) if want_ctx else None
    return y, yc


def s5_glu(y, w_glu):
    g = jax.nn.gelu(y.reshape(y.shape[0], y.shape[1], SSM_WIDTH))
    return g * jax.nn.sigmoid(g @ w_glu)


def s5_bidirectional(u, uc, lam_re, lam_im, log_dt, b_re, b_im, c_re, c_im, d_skip, w_glu, want_ctx):
    d = d_skip.astype(jnp.float32).reshape(SSM_GROUPS, SSM_GROUP)
    y = d * u.astype(jnp.float32)
    yc = d * uc.astype(jnp.float32) if want_ctx else None
    for direction, reverse in ((0, False), (1, True)):
        yd, ycd = s5_direction(u, uc, lam_re[direction], lam_im[direction], log_dt[direction],
                               b_re[direction], b_im[direction], c_re[direction], c_im[direction],
                               reverse, want_ctx)
        y = y + yd
        if want_ctx:
            yc = yc + ycd
    out = s5_glu(y, w_glu).astype(u.dtype)
    out_c = s5_glu(yc, w_glu).astype(uc.dtype) if want_ctx else None
    return out, out_c


def attn_ssm_mixer(h, hc, cos, sin, w_in, q_gain, k_gain, sink, lam_re, lam_im, log_dt,
                   b_re, b_im, c_re, c_im, d_skip, w_glu, w_out, want_ctx):
    q, k, v, u = project_heads(h, w_in, q_gain, k_gain, True)
    qc, kc, vc, uc = project_heads(hc, w_in, q_gain, k_gain, want_ctx)
    q = apply_rope(q, cos, sin)
    k = apply_rope(k, cos, sin)
    attn = window_attention(q, k, v, kc, vc, sink)
    ssm, ssm_c = s5_bidirectional(u, uc, lam_re, lam_im, log_dt, b_re, b_im, c_re, c_im,
                                  d_skip, w_glu, want_ctx)
    y = jnp.concatenate([attn, ssm.astype(attn.dtype)], axis=-1) @ w_out
    if not want_ctx:
        return y, None
    attn_c = context_attention(qc, kc, vc, sink)
    yc = jnp.concatenate([attn_c, ssm_c.astype(attn_c.dtype)], axis=-1) @ w_out
    return y, yc


def fourier_mix(h, w):
    b, n, d = h.shape
    hg = h.astype(jnp.float32).reshape(b, n, FOURIER_GROUPS, FOURIER_GROUP_WIDTH)
    f = jnp.fft.fftn(hg, axes=(1, 3), norm="ortho").real
    return f.reshape(b, n, d).astype(h.dtype) @ w


def odd_layer_stream(s, gains, mod, w1, w3, w2, w_f):
    s = half_ffn(s, gains[0], mod[0:3], w1[0], w3[0], w2[0])
    h = modulate(rms_norm(s, gains[1]), mod[3], mod[4])
    s = s + mod[5] * fourier_mix(h, w_f)
    return half_ffn(s, gains[2], mod[6:9], w1[1], w3[1], w2[1])


def setup_inputs(seed: int = 0) -> dict:
    key = jax.random.key(seed)
    ks = jax.random.split(key, 25)
    f32 = jnp.float32
    D, F, G, P = D_MODEL, D_FF, SSM_GROUPS, SSM_STATE

    def nrm(k, shape, scale):
        return scale * jax.random.normal(k, shape, f32)

    lam_im0 = jnp.pi * jnp.arange(P, dtype=f32)
    return {
        "x": nrm(ks[0], (BATCH, SEQ, D), 1.0),
        "c": nrm(ks[1], (BATCH, D), 1.0),
        "ctx": nrm(ks[2], (BATCH, CTX_LEN, D), 1.0),
        "c_ctx": nrm(ks[3], (D,), 1.0),
        "w_ada": nrm(ks[4], (DEPTH, D, N_MOD * D), D ** -0.5),
        "b_ada": nrm(ks[5], (DEPTH, N_MOD * D), 0.01),
        "norm_gain": 1.0 + nrm(ks[6], (DEPTH, 3, D), 0.02),
        "ffn_w1": nrm(ks[7], (DEPTH, 2, D, F), D ** -0.5),
        "ffn_w3": nrm(ks[8], (DEPTH, 2, D, F), D ** -0.5),
        "ffn_w2": nrm(ks[9], (DEPTH, 2, F, D), F ** -0.5),
        "w_in": nrm(ks[10], (N_EVEN, D, IN_WIDTH), D ** -0.5),
        "q_gain": 1.0 + nrm(ks[11], (N_EVEN, HEAD_DIM), 0.02),
        "k_gain": 1.0 + nrm(ks[12], (N_EVEN, HEAD_DIM), 0.02),
        "sink_logit": nrm(ks[13], (N_EVEN, N_Q_HEADS), 0.5),
        "ssm_lam_re": -0.5 + nrm(ks[14], (N_EVEN, 2, G, P), 0.01),
        "ssm_lam_im": lam_im0 + nrm(ks[15], (N_EVEN, 2, G, P), 0.01),
        "ssm_log_dt": jax.random.uniform(ks[16], (N_EVEN, 2, G), f32, math.log(DT_MIN), math.log(DT_MAX)),
        "ssm_b_re": nrm(ks[17], (N_EVEN, 2, G, P, SSM_GROUP), (2 * SSM_GROUP) ** -0.5),
        "ssm_b_im": nrm(ks[18], (N_EVEN, 2, G, P, SSM_GROUP), (2 * SSM_GROUP) ** -0.5),
        "ssm_c_re": nrm(ks[19], (N_EVEN, 2, G, SSM_GROUP, P), P ** -0.5),
        "ssm_c_im": nrm(ks[20], (N_EVEN, 2, G, SSM_GROUP, P), P ** -0.5),
        "ssm_d": nrm(ks[21], (N_EVEN, SSM_WIDTH), 1.0),
        "ssm_w_glu": nrm(ks[22], (N_EVEN, SSM_WIDTH, SSM_WIDTH), SSM_WIDTH ** -0.5),
        "w_out": nrm(ks[23], (N_EVEN, D, D), D ** -0.5),
        "fourier_w_out": nrm(ks[24], (N_ODD, D, D), D ** -0.5),
    }


def reference(x, c, ctx, c_ctx, w_ada, b_ada, norm_gain, ffn_w1, ffn_w3, ffn_w2, w_in, q_gain, k_gain,
              sink_logit, ssm_lam_re, ssm_lam_im, ssm_log_dt, ssm_b_re, ssm_b_im, ssm_c_re, ssm_c_im,
              ssm_d, ssm_w_glu, w_out, fourier_w_out):
    n_lat = x.shape[1]
    rows = n_lat // GRID_W
    cos, sin = axial_rope_tables(rows)
    s_ctx = ctx
    for layer in range(DEPTH):
        even = layer % 2 == 0
        ctx_later = any(j % 2 == 0 for j in range(layer + 1, DEPTH))
        gains = norm_gain[layer]
        w1, w3, w2 = ffn_w1[layer], ffn_w3[layer], ffn_w2[layer]
        m = ada_mod(c, w_ada[layer], b_ada[layer])
        if even:
            e = layer // 2
            mc = ada_mod(c_ctx, w_ada[layer], b_ada[layer])
            x = half_ffn(x, gains[0], m[0:3], w1[0], w3[0], w2[0])
            s_ctx = half_ffn(s_ctx, gains[0], mc[0:3], w1[0], w3[0], w2[0])
            h = modulate(rms_norm(x, gains[1]), m[3], m[4])
            hc = modulate(rms_norm(s_ctx, gains[1]), mc[3], mc[4])
            y, yc = attn_ssm_mixer(h, hc, cos, sin, w_in[e], q_gain[e], k_gain[e], sink_logit[e],
                                   ssm_lam_re[e], ssm_lam_im[e], ssm_log_dt[e], ssm_b_re[e], ssm_b_im[e],
                                   ssm_c_re[e], ssm_c_im[e], ssm_d[e], ssm_w_glu[e], w_out[e], ctx_later)
            x = x + m[5] * y
            x = half_ffn(x, gains[2], m[6:9], w1[1], w3[1], w2[1])
            if ctx_later:
                s_ctx = s_ctx + mc[5] * yc
                s_ctx = half_ffn(s_ctx, gains[2], mc[6:9], w1[1], w3[1], w2[1])
        else:
            o = layer // 2
            x = odd_layer_stream(x, gains, m, w1, w3, w2, fourier_w_out[o])
            if ctx_later:
                mc = ada_mod(c_ctx, w_ada[layer], b_ada[layer])
                s_ctx = odd_layer_stream(s_ctx, gains, mc, w1, w3, w2, fourier_w_out[o])
    return x
```

```cpp
#include <hip/hip_runtime.h>
#include <hip/hip_cooperative_groups.h>
#include <cstdio>
#include <cstdint>
namespace cg = cooperative_groups;

#define LAS __attribute__((address_space(3)))
typedef unsigned short bf16_t;
typedef short bf16x8 __attribute__((ext_vector_type(8)));
typedef float f32x4 __attribute__((ext_vector_type(4)));
typedef unsigned u32x4 __attribute__((ext_vector_type(4)));
typedef unsigned u32x2 __attribute__((ext_vector_type(2)));

constexpr int D = 1024, NB = 8, SEQ = 4096, MX = NB * SEQ, CTXL = 256, MC = NB * CTXL, MALL = MX + MC;
constexpr int FF = 2816, NUP = 2 * FF, INW = 1280, QKVW = 768;
constexpr int KPL = SEQ + CTXL;
constexpr int A2K = 768, A2ROWS = 1280;
constexpr float LOG2E = 1.4426950408889634f;

constexpr size_t MiB = 1u << 20;
constexpr size_t WS_MOD = 0;
constexpr size_t WS_CTXS = 1 * MiB;
constexpr size_t WS_W256 = 9 * MiB;
constexpr size_t WS_CS256 = 9 * MiB + 512 * 1024;
constexpr size_t WS_BAR = 10 * MiB + 512 * 1024;
constexpr size_t WS_AT = 10 * MiB;
constexpr size_t WS_WINT = 11 * MiB;
constexpr size_t WS_WOUTT = 14 * MiB;
constexpr size_t WS_WGLUT = 16 * MiB;
constexpr size_t WS_WFT = 17 * MiB;
constexpr size_t WS_W13T = 19 * MiB;
constexpr size_t WS_W2T = 63 * MiB;
constexpr size_t WS_TC = 85 * MiB;
constexpr size_t WS_BS = 109 * MiB;
constexpr size_t WS_ACT = 117 * MiB;
constexpr size_t WS_HN = 304 * MiB;
constexpr size_t WS_EXTRA = 372 * MiB;
constexpr size_t WS_END = 485 * MiB;
constexpr size_t WS_QKV = WS_ACT;
constexpr size_t WS_A2 = WS_ACT + 52 * MiB;
constexpr size_t WS_S = WS_ACT + 112 * MiB;
constexpr size_t WS_QP = WS_ACT + 152 * MiB;
constexpr size_t WS_KP = WS_EXTRA;
constexpr size_t WS_VT = WS_EXTRA + 9 * MiB;
constexpr size_t WS_G = WS_EXTRA + 18 * MiB;
constexpr size_t WS_MIX = WS_EXTRA + 50 * MiB;
constexpr size_t WS_GT = WS_ACT;
constexpr size_t WS_HT = WS_HN;
constexpr size_t WS_F = WS_ACT;
static_assert(WS_MIX + (size_t)MX * 1024 * 2 <= WS_END + MiB, "mix fits");
constexpr size_t WS_NEED = WS_END + MiB;

constexpr int LDS_BYTES = 147456;

__device__ __forceinline__ unsigned cvt_pk_bf16(float lo, float hi) { unsigned r; asm("v_cvt_pk_bf16_f32 %0, %1, %2" : "=v"(r) : "v"(lo), "v"(hi)); return r; }
__device__ __forceinline__ bf16_t f2bf(float f) { return (bf16_t)(cvt_pk_bf16(f, 0.f) & 0xffffu); }
__device__ __forceinline__ float bf2f(unsigned h) { return __builtin_bit_cast(float, h << 16); }
__device__ __forceinline__ float wave_sum(float v) {
#pragma unroll
    for (int o = 1; o < 64; o <<= 1) v += __shfl_xor(v, o);
    return v;
}
__device__ __forceinline__ float fast_sigmoid(float x) { return __builtin_amdgcn_rcpf(1.0f + __builtin_amdgcn_exp2f(-x * LOG2E)); }
__device__ __forceinline__ float gelu_tanh(float x) { const float u = 0.7978845608028654f * (x + 0.044715f * x * x * x); return x * fast_sigmoid(2.0f * u); }

namespace pg8 {
constexpr int BM = 256, BK = 64, HALF = 128, HTB = HALF * BK * 2, STAGE_BYTES = 8 * HTB, NXCD = 8, WGM = 8;
__device__ __forceinline__ int lds_byte(int r, int c) { const int st = (r >> 4) * 2 + (c >> 5), rr = r & 15, cc = c & 31, ob = rr * 64 + cc * 2; return st * 1024 + (ob ^ (((ob >> 9) & 1) << 5)); }
__device__ __forceinline__ void stage_rc(int b, int& R, int& C) { const int st = b / 1024, sb = b % 1024, swz = sb ^ (((sb >> 9) & 1) << 5); R = (st >> 1) * 16 + swz / 64; C = (st & 1) * 32 + (swz % 64) / 2; }
struct Unit { int pm, pn; size_t aoff, boff; int nt; };
struct Gemm { const bf16_t* A; const bf16_t* Bt; int K, lda, ldb; unsigned gstride; };

template <class Epi, class Sched, bool SWAPD = false>
__device__ __forceinline__ void gemm_phase(LAS unsigned char* lds, const Gemm g, const Sched& S, const Epi& E) {
    int tid_ = threadIdx.x; asm volatile("" : "+v"(tid_));
    const int tid = tid_, wid = __builtin_amdgcn_readfirstlane(tid >> 6), lane = tid & 63, wr = wid >> 2, wc = wid & 3, fr = lane & 15, fq = lane >> 4;
    const int ntK = g.K / BK;
    unsigned voffA[2], voffB[2];
#pragma unroll
    for (int i = 0; i < 2; ++i) { int R, C; stage_rc(tid * 16 + i * 8192, R, C); voffA[i] = g.gstride ? (unsigned)(R * 16 + (C & 15)) * 2u + (unsigned)(C >> 4) * g.gstride : (unsigned)(R * g.lda + C) * 2u; voffB[i] = (unsigned)(R * g.ldb + C) * 2u; }
    const size_t kstep = (size_t)(BK * 2), kstepA = g.gstride ? (size_t)4 * g.gstride : kstep;
    const size_t hstepA = (size_t)HALF * g.lda * 2, hstepB = (size_t)HALF * g.ldb * 2;
    const unsigned ldsw = (unsigned)wid * 1024u;
    const int aoff = lds_byte(wr * 64 + fr, fq * 8), boff = lds_byte(wc * 32 + fr, fq * 8);
#define PG8_SA(b, h) (((b) * 2 + (h)) * HTB)
#define PG8_SB(b, h) ((4 + (b) * 2 + (h)) * HTB)
#define PG8_STAGE(bufoff, gbase, voff) do { _Pragma("unroll") for (int _i = 0; _i < 2; ++_i) \
        __builtin_amdgcn_global_load_lds((const unsigned*)((const char*)(gbase) + (voff)[_i]), (LAS unsigned*)(lds + (bufoff) + ldsw + _i * 8192), 16, 0, 0); } while (0)
#define PG8_LDA(dst, b, h) do { _Pragma("unroll") for (int m = 0; m < 4; ++m) _Pragma("unroll") for (int k = 0; k < 2; ++k) dst[m][k] = *(const LAS bf16x8*)(lds + PG8_SA(b, h) + aoff + m * 2048 + k * 1024); } while (0)
#define PG8_LDB(dst, b, h) do { _Pragma("unroll") for (int n = 0; n < 2; ++n) _Pragma("unroll") for (int k = 0; k < 2; ++k) dst[n][k] = *(const LAS bf16x8*)(lds + PG8_SB(b, h) + boff + n * 2048 + k * 1024); } while (0)
#define PG8_MMA(ai, bj, At, Bt) do { __builtin_amdgcn_s_setprio(1); _Pragma("unroll") for (int k = 0; k < 2; ++k) _Pragma("unroll") for (int m = 0; m < 4; ++m) _Pragma("unroll") for (int n = 0; n < 2; ++n) \
        acc[ai][bj][m][n] = SWAPD ? __builtin_amdgcn_mfma_f32_16x16x32_bf16(At[m][k], Bt[n][k], acc[ai][bj][m][n], 0, 0, 0) : __builtin_amdgcn_mfma_f32_16x16x32_bf16(Bt[n][k], At[m][k], acc[ai][bj][m][n], 0, 0, 0); __builtin_amdgcn_s_setprio(0); } while (0)
#define PG8_WAIT_V(n) asm volatile("s_waitcnt vmcnt(" #n ")" ::: "memory")
#define PG8_WAIT_L(n) asm volatile("s_waitcnt lgkmcnt(" #n ")" ::: "memory")
#define PG8_BAR __builtin_amdgcn_s_barrier()
#define PG8_SCHED __builtin_amdgcn_sched_barrier(0)
    Unit cur, nxt; int ui = 0;
    if (!S.next(0, cur)) return;
    f32x4 acc[2][2][4][2];
#pragma unroll
    for (int a = 0; a < 2; ++a)
#pragma unroll
        for (int b = 0; b < 2; ++b)
#pragma unroll
            for (int m = 0; m < 4; ++m)
#pragma unroll
                for (int n = 0; n < 2; ++n) acc[a][b][m][n] = (f32x4){0.f, 0.f, 0.f, 0.f};
    bf16x8 At[4][2], B0[2][2], B1[2][2];
    const char* cA = (const char*)g.A + cur.aoff; const char* cB = (const char*)g.Bt + cur.boff;
    PG8_STAGE(PG8_SB(0, 0), cB, voffB); PG8_STAGE(PG8_SB(0, 1), cB + hstepB, voffB); PG8_STAGE(PG8_SA(0, 0), cA, voffA); PG8_STAGE(PG8_SA(0, 1), cA + hstepA, voffA);
    if (wr == 1) PG8_BAR;
    PG8_WAIT_V(2); PG8_BAR;
    PG8_STAGE(PG8_SB(1, 0), cB + kstep, voffB); PG8_STAGE(PG8_SA(1, 0), cA + kstepA, voffA); PG8_STAGE(PG8_SB(1, 1), cB + hstepB + kstep, voffB);
    PG8_WAIT_V(6); PG8_BAR;
    for (;;) {
        const bool has_next = S.next(ui + 1, nxt);
        const char* nA = has_next ? (const char*)g.A + nxt.aoff : cA; const char* nB = has_next ? (const char*)g.Bt + nxt.boff : cB;
        const int nt = cur.nt ? cur.nt : ntK;
        for (int t = 0; t < nt; t += 2) {
            const bool last = (t == nt - 2);
            const char* a1 = cA + (size_t)(t + 1) * kstepA;
            const char* a2 = last ? nA : cA + (size_t)(t + 2) * kstepA; const char* b2 = last ? nB : cB + (size_t)(t + 2) * kstep;
            const char* a3 = a2 + kstepA; const char* b3 = b2 + kstep;
            PG8_LDB(B0, 0, 0); PG8_LDB(B1, 0, 1); PG8_SCHED; PG8_LDA(At, 0, 0); PG8_STAGE(PG8_SA(1, 1), a1 + hstepA, voffA);
            PG8_WAIT_V(8); PG8_WAIT_L(0); PG8_BAR; PG8_MMA(0, 0, At, B0); PG8_MMA(0, 1, At, B1); PG8_BAR; PG8_SCHED;
            PG8_LDA(At, 0, 1); PG8_STAGE(PG8_SB(0, 0), b2, voffB); PG8_STAGE(PG8_SB(0, 1), b2 + hstepB, voffB); PG8_STAGE(PG8_SA(0, 0), a2, voffA);
            PG8_WAIT_V(8); PG8_WAIT_L(0); PG8_BAR; PG8_MMA(1, 0, At, B0); PG8_MMA(1, 1, At, B1); PG8_BAR; PG8_SCHED;
            PG8_LDB(B0, 1, 0); PG8_LDB(B1, 1, 1); PG8_SCHED; PG8_LDA(At, 1, 0); PG8_STAGE(PG8_SA(0, 1), a2 + hstepA, voffA);
            PG8_WAIT_V(8); PG8_WAIT_L(0); PG8_BAR; PG8_MMA(0, 0, At, B0); PG8_MMA(0, 1, At, B1); PG8_BAR; PG8_SCHED;
            PG8_LDA(At, 1, 1); PG8_STAGE(PG8_SB(1, 0), b3, voffB); PG8_STAGE(PG8_SB(1, 1), b3 + hstepB, voffB); PG8_STAGE(PG8_SA(1, 0), a3, voffA);
            PG8_WAIT_V(8); PG8_WAIT_L(0); PG8_BAR; PG8_MMA(1, 0, At, B0); PG8_MMA(1, 1, At, B1); PG8_BAR; PG8_SCHED;
        }
        if (wr == 0) PG8_BAR;
        E(acc, cur, wr, wc, fr, fq);
        if (!has_next) break;
#pragma unroll
        for (int a = 0; a < 2; ++a)
#pragma unroll
            for (int b = 0; b < 2; ++b)
#pragma unroll
                for (int m = 0; m < 4; ++m)
#pragma unroll
                    for (int n = 0; n < 2; ++n) acc[a][b][m][n] = (f32x4){0.f, 0.f, 0.f, 0.f};
        cur = nxt; cA = nA; cB = nB; ++ui;
        if (wr == 1) PG8_BAR;
    }
    PG8_WAIT_V(0);
    PG8_BAR;
#undef PG8_SA
#undef PG8_SB
#undef PG8_STAGE
#undef PG8_LDA
#undef PG8_LDB
#undef PG8_MMA
#undef PG8_WAIT_V
#undef PG8_WAIT_L
#undef PG8_BAR
#undef PG8_SCHED
}
}
using pg8::Unit;

struct MapPlain {
    int nM, nN; size_t ta, tb;
    __device__ __forceinline__ int total() const { return nM * nN; }
    __device__ __forceinline__ void operator()(int L, Unit& u) const {
        const int nwg = nM * nN; int wgid = L; { const int q = nwg / 8, r = nwg % 8, xcd = wgid % 8, off = wgid / 8; wgid = (xcd < r ? xcd * (q + 1) : r * (q + 1) + (xcd - r) * q) + off; }
        const int nig = 8 * nN, gid = wgid / nig, fm = gid * 8, gsz = (nM - fm) < 8 ? (nM - fm) : 8;
        u.pm = fm + ((wgid % nig) % gsz); u.pn = (wgid % nig) / gsz; u.aoff = (size_t)u.pm * ta; u.boff = (size_t)u.pn * tb; u.nt = 0;
    }
};
struct MapDn1 {
    MapPlain x;
    __device__ __forceinline__ int total() const { return 512 + 128; }
    __device__ __forceinline__ void operator()(int L, Unit& u) const {
        if (L < 512) { x(L, u); return; }
        const int q = L - 512, tile = q >> 2, sp = q & 3, pmc = tile >> 2, pn = tile & 3, kt0 = sp == 0 ? 0 : (sp == 1 ? 12 : (sp == 2 ? 24 : 34));
        u.pm = 128 + pmc; u.pn = pn | (sp << 4); u.nt = sp < 2 ? 12 : 10;
        u.aoff = ((size_t)u.pm * 256 * FF + kt0 * 64) * 2; u.boff = ((size_t)pn * 256 * FF + kt0 * 64) * 2;
    }
};
struct MapS {
    __device__ __forceinline__ int total() const { return 32 * 5; }
    __device__ __forceinline__ void operator()(int L, Unit& u) const { const int g = L / 5, pml = L % 5; u.pm = g * 5 + pml; u.pn = g; u.aoff = (size_t)u.pm * 256 * A2K * 2; u.boff = (size_t)g * 256 * 512 * 2; u.nt = 0; }
};
struct MapY {
    __device__ __forceinline__ int total() const { return 32 * 8; }
    __device__ __forceinline__ void operator()(int L, Unit& u) const { const int g = L >> 3, pml = (L >> 1) & 3, pnl = L & 1; u.pm = g * 5 + pml; u.pn = g * 2 + pnl; u.aoff = (size_t)u.pm * 256 * A2K * 2; u.boff = ((size_t)g * 512 + pnl * 256) * A2K * 2; u.nt = 0; }
};
struct MapB {
    __device__ __forceinline__ int total() const { return 128 * 4; }
    __device__ __forceinline__ void operator()(int L, Unit& u) const { u.pm = L >> 2; u.pn = L & 3; u.aoff = ((size_t)u.pm * 256 * 2048 + (size_t)u.pn * 512) * 2; u.boff = 0; u.nt = 0; }
};
template <class Map> struct Sched {
    Map map; int G, c;
    __device__ __forceinline__ bool next(int i, Unit& u) const { const long L = (long)i * G + c; if (L >= map.total()) return false; map((int)L, u); return true; }
};

typedef f32x4 Acc[2][2][4][2];
struct EpiSwiglu {
    bf16_t* ACT;
    __device__ __forceinline__ void operator()(const Acc& acc, const Unit& u, int wr, int wc, int fr, int fq) const {
        const int row0 = u.pm * 256 + wr * 64 + fr, h0 = u.pn * 128 + wc * 32 + 8 * fq;
#pragma unroll
        for (int ai = 0; ai < 2; ++ai)
#pragma unroll
            for (int m = 0; m < 4; ++m) { bf16_t* rp = ACT + (size_t)(row0 + ai * 128 + m * 16) * FF + h0; float v[8];
#pragma unroll
                for (int n = 0; n < 2; ++n) { const f32x4 a = acc[ai][0][m][n], b = acc[ai][1][m][n];
                    const f32x4 t = a * (-LOG2E); f32x4 e; e.x = __builtin_amdgcn_exp2f(t.x); e.y = __builtin_amdgcn_exp2f(t.y); e.z = __builtin_amdgcn_exp2f(t.z); e.w = __builtin_amdgcn_exp2f(t.w);
                    const f32x4 d = e + 1.0f; f32x4 r; r.x = __builtin_amdgcn_rcpf(d.x); r.y = __builtin_amdgcn_rcpf(d.y); r.z = __builtin_amdgcn_rcpf(d.z); r.w = __builtin_amdgcn_rcpf(d.w);
                    const f32x4 o = (a * b) * r; v[4 * n + 0] = o.x; v[4 * n + 1] = o.y; v[4 * n + 2] = o.z; v[4 * n + 3] = o.w; }
                u32x4 w; w.x = cvt_pk_bf16(v[0], v[1]); w.y = cvt_pk_bf16(v[2], v[3]); w.z = cvt_pk_bf16(v[4], v[5]); w.w = cvt_pk_bf16(v[6], v[7]); *(u32x4*)rp = w; }
    }
};
template <bool SRC32, bool DST32> struct EpiResidT {
    const void* srcx; const void* srcc; void* dstx; void* dstc; const float* gate; float f;
    __device__ __forceinline__ void operator()(const Acc& acc, const Unit& u, int wr, int wc, int fr, int fq) const {
        const bool isx = u.pm < 128; const int mb = isx ? (u.pm >> 4) : 8;
        const size_t tile0 = (size_t)(isx ? u.pm : u.pm - 128) * 256 * D;
        const float* sp32 = (const float*)(isx ? srcx : srcc) + tile0; const bf16_t* sp16 = (const bf16_t*)(isx ? srcx : srcc) + tile0;
        float* dp32 = (float*)(isx ? dstx : dstc) + tile0; bf16_t* dp16 = (bf16_t*)(isx ? dstx : dstc) + tile0;
        const int r0 = wr * 64 + fr, col0 = u.pn * 256 + wc * 32 + 8 * fq; const float* gp = gate + (size_t)mb * 9216 + col0;
        f32x4 gv[2][2];
#pragma unroll
        for (int bj = 0; bj < 2; ++bj)
#pragma unroll
            for (int n = 0; n < 2; ++n) gv[bj][n] = *(const f32x4*)(gp + bj * 128 + n * 4) * f;
#pragma unroll
        for (int ai = 0; ai < 2; ++ai)
#pragma unroll
            for (int m = 0; m < 4; ++m) { const size_t off = (size_t)(r0 + ai * 128 + m * 16) * D + col0;
#pragma unroll
                for (int bj = 0; bj < 2; ++bj) { const size_t o2 = off + bj * 128; f32x4 s0, s1;
                    if (SRC32) { s0 = *(const f32x4*)(sp32 + o2); s1 = *(const f32x4*)(sp32 + o2 + 4); }
                    else { const u32x4 q = *(const u32x4*)(sp16 + o2); s0 = (f32x4){bf2f(q.x & 0xffffu), bf2f(q.x >> 16), bf2f(q.y & 0xffffu), bf2f(q.y >> 16)}; s1 = (f32x4){bf2f(q.z & 0xffffu), bf2f(q.z >> 16), bf2f(q.w & 0xffffu), bf2f(q.w >> 16)}; }
                    const f32x4 v0 = s0 + gv[bj][0] * acc[ai][bj][m][0], v1 = s1 + gv[bj][1] * acc[ai][bj][m][1];
                    if (DST32) { *(f32x4*)(dp32 + o2) = v0; *(f32x4*)(dp32 + o2 + 4) = v1; }
                    else { u32x4 w; w.x = cvt_pk_bf16(v0.x, v0.y); w.y = cvt_pk_bf16(v0.z, v0.w); w.z = cvt_pk_bf16(v1.x, v1.y); w.w = cvt_pk_bf16(v1.z, v1.w); *(u32x4*)(dp16 + o2) = w; } } }
    }
};
struct EpiDn1 {
    EpiResidT<true, false> R; float* P;
    __device__ __forceinline__ void operator()(const Acc& acc, const Unit& u, int wr, int wc, int fr, int fq) const {
        if (u.pm < 128) { R(acc, u, wr, wc, fr, fq); return; }
        const int sp = u.pn >> 4, pn = u.pn & 15; float* pp = P + ((size_t)sp * MC + (size_t)(u.pm - 128) * 256) * D;
        const int r0 = wr * 64 + fr, col0 = pn * 256 + wc * 32 + 8 * fq;
#pragma unroll
        for (int ai = 0; ai < 2; ++ai)
#pragma unroll
            for (int m = 0; m < 4; ++m) { float* rp = pp + (size_t)(r0 + ai * 128 + m * 16) * D + col0;
#pragma unroll
                for (int bj = 0; bj < 2; ++bj) { *(f32x4*)(rp + bj * 128) = acc[ai][bj][m][0]; *(f32x4*)(rp + bj * 128 + 4) = acc[ai][bj][m][1]; } }
    }
};
struct EpiInproj {
    bf16_t* QKV; bf16_t* A2;
    __device__ __forceinline__ void operator()(const Acc& acc, const Unit& u, int wr, int wc, int fr, int fq) const {
        const int row0 = u.pm * 256 + wr * 64 + fr;
#pragma unroll
        for (int ai = 0; ai < 2; ++ai)
#pragma unroll
            for (int m = 0; m < 4; ++m) { const int row = row0 + ai * 128 + m * 16;
#pragma unroll
                for (int bj = 0; bj < 2; ++bj) { const f32x4 a = acc[ai][bj][m][0], b = acc[ai][bj][m][1];
                    u32x4 w; w.x = cvt_pk_bf16(a[0], a[1]); w.y = cvt_pk_bf16(a[2], a[3]); w.z = cvt_pk_bf16(b[0], b[1]); w.w = cvt_pk_bf16(b[2], b[3]);
                    if (u.pn < 3) { const int col = u.pn * 256 + bj * 128 + wc * 32 + 8 * fq; *(u32x4*)(QKV + (size_t)row * QKVW + col) = w; }
                    else { const int g = (u.pn - 3) * 16 + bj * 8 + wc * 2 + (fq >> 1); *(u32x4*)(A2 + ((size_t)g * A2ROWS + (row >> 5)) * A2K + (row & 31) * 16 + 8 * (fq & 1)) = w; } } }
    }
};
struct EpiS {
    float* S;
    __device__ __forceinline__ void operator()(const Acc& acc, const Unit& u, int wr, int wc, int fr, int fq) const {
        const int row0 = u.pm * 256 + wr * 64 + fr, col0 = wc * 32 + 4 * fq;
#pragma unroll
        for (int ai = 0; ai < 2; ++ai)
#pragma unroll
            for (int m = 0; m < 4; ++m) { float* rp = S + (size_t)(row0 + ai * 128 + m * 16) * 256 + col0;
#pragma unroll
                for (int bj = 0; bj < 2; ++bj)
#pragma unroll
                    for (int n = 0; n < 2; ++n) *(f32x4*)(rp + bj * 128 + n * 16) = acc[ai][bj][m][n]; }
    }
};
struct EpiY {
    bf16_t* G;
    __device__ __forceinline__ void operator()(const Acc& acc, const Unit& u, int wr, int wc, int fr, int fq) const {
        const int g = u.pm / 5, pml = u.pm % 5, pnl = u.pn & 1;
#pragma unroll
        for (int ai = 0; ai < 2; ++ai)
#pragma unroll
            for (int m = 0; m < 4; ++m) { const int nrow = pml * 256 + ai * 128 + wr * 64 + m * 16 + fr;
#pragma unroll
                for (int bj = 0; bj < 2; ++bj)
#pragma unroll
                    for (int n = 0; n < 2; ++n) { const int t = pnl * 16 + bj * 8 + wc * 2 + n; const f32x4 a = acc[ai][bj][m][n];
                        u32x2 w; w.x = cvt_pk_bf16(gelu_tanh(a[0]), gelu_tanh(a[1])); w.y = cvt_pk_bf16(gelu_tanh(a[2]), gelu_tanh(a[3]));
                        *(u32x2*)(G + ((size_t)g * MX + nrow * 32 + t) * 16 + 4 * fq) = w; } }
    }
};
struct EpiGlu {
    const bf16_t* G; bf16_t* MIX;
    __device__ __forceinline__ void operator()(const Acc& acc, const Unit& u, int wr, int wc, int fr, int fq) const {
        const int row0 = u.pm * 256 + wr * 64 + fr, col0 = u.pn * 256 + wc * 32 + 8 * fq;
#pragma unroll
        for (int ai = 0; ai < 2; ++ai)
#pragma unroll
            for (int m = 0; m < 4; ++m) { const int row = row0 + ai * 128 + m * 16;
#pragma unroll
                for (int bj = 0; bj < 2; ++bj) { const int col = col0 + bj * 128; const u32x4 gw = *(const u32x4*)(G + ((size_t)(col >> 4) * MX + row) * 16 + (col & 15)); const f32x4 a = acc[ai][bj][m][0], b = acc[ai][bj][m][1];
                    u32x4 w; w.x = cvt_pk_bf16(bf2f(gw.x & 0xffffu) * fast_sigmoid(a[0]), bf2f(gw.x >> 16) * fast_sigmoid(a[1])); w.y = cvt_pk_bf16(bf2f(gw.y & 0xffffu) * fast_sigmoid(a[2]), bf2f(gw.y >> 16) * fast_sigmoid(a[3]));
                    w.z = cvt_pk_bf16(bf2f(gw.z & 0xffffu) * fast_sigmoid(b[0]), bf2f(gw.z >> 16) * fast_sigmoid(b[1])); w.w = cvt_pk_bf16(bf2f(gw.w & 0xffffu) * fast_sigmoid(b[2]), bf2f(gw.w >> 16) * fast_sigmoid(b[3]));
                    *(u32x4*)(MIX + (size_t)row * 1024 + 512 + col) = w; } }
    }
};
struct EpiDftA {
    bf16_t* HT;
    __device__ __forceinline__ void operator()(const Acc& acc, const Unit& u, int wr, int wc, int fr, int fq) const {
        const int bk = u.pm >> 2, gr = u.pm & 3, b = bk / 9, ka = bk % 9, ri = u.pn; const bool mir = ka >= 1 && ka <= 7; const unsigned sgn = ri ? 0x80008000u : 0u;
#pragma unroll
        for (int ai = 0; ai < 2; ++ai)
#pragma unroll
            for (int m = 0; m < 4; ++m) { const int cc = ai * 128 + wr * 64 + m * 16 + 4 * fq; bf16_t* cp = HT + (size_t)gr * 512 + ri * 256 + cc;
#pragma unroll
                for (int bj = 0; bj < 2; ++bj)
#pragma unroll
                    for (int n = 0; n < 2; ++n) { const f32x4 a = acc[ai][bj][m][n]; const int kb = bj * 128 + wc * 32 + n * 16 + fr;
                        u32x2 w; w.x = cvt_pk_bf16(a[0], a[1]); w.y = cvt_pk_bf16(a[2], a[3]); *(u32x2*)(cp + (size_t)(b * 4096 + ka + 16 * kb) * 2048) = w;
                        if (mir) { u32x2 w2; w2.x = w.x ^ sgn; w2.y = w.y ^ sgn; *(u32x2*)(cp + (size_t)(b * 4096 + (16 - ka) + 16 * (255 - kb)) * 2048) = w2; } } }
    }
};
struct EpiF {
    bf16_t* F;
    __device__ __forceinline__ void operator()(const Acc& acc, const Unit& u, int wr, int wc, int fr, int fq) const {
        const int row0 = u.pm * 256 + wr * 64 + fr, col0 = u.pn * 256 + wc * 32 + 4 * fq;
#pragma unroll
        for (int ai = 0; ai < 2; ++ai)
#pragma unroll
            for (int m = 0; m < 4; ++m) { bf16_t* rp = F + (size_t)(row0 + ai * 128 + m * 16) * 1024 + col0;
#pragma unroll
                for (int bj = 0; bj < 2; ++bj)
#pragma unroll
                    for (int n = 0; n < 2; ++n) { const f32x4 a = acc[ai][bj][m][n] * (1.0f / 1024.0f); u32x2 w; w.x = cvt_pk_bf16(a[0], a[1]); w.y = cvt_pk_bf16(a[2], a[3]); *(u32x2*)(rp + bj * 128 + n * 16) = w; } }
    }
};

struct Ctx { unsigned char* lds; int tid, lane, wave, G, bx, gw, NGW; };
__device__ __forceinline__ Ctx mkctx(unsigned char* lds) {
    Ctx X; int t = threadIdx.x; asm volatile("" : "+v"(t)); X.lds = lds; X.tid = t; X.lane = t & 63; X.wave = __builtin_amdgcn_readfirstlane(t >> 6); X.G = gridDim.x; X.bx = blockIdx.x; X.gw = X.bx * 8 + X.wave; X.NGW = X.G * 8; return X;
}

__device__ __forceinline__ int permrow(int c) { return (c & ~31) + 16 * ((c >> 2) & 1) + 4 * ((c >> 3) & 3) + (c & 3); }
template <int MODE>
__device__ __forceinline__ void tr_item(const float* __restrict__ W, int K, int N, bf16_t* WT, float* scr, int item, int lane) {
    const int nblk = N / 32, kb = item / nblk, nb = item % nblk, k0 = 64 * kb, n0 = 32 * nb;
    float tv[32];
#pragma unroll
    for (int i = 0; i < 32; ++i) tv[i] = W[(size_t)(k0 + 2 * i + (lane >> 5)) * N + n0 + (lane & 31)];
#pragma unroll
    for (int i = 0; i < 32; ++i) scr[(2 * i + (lane >> 5)) * 33 + (lane & 31)] = tv[i];
    asm volatile("s_waitcnt lgkmcnt(0)" ::: "memory");
    const int c = lane & 7;
#pragma unroll
    for (int j = 0; j < 4; ++j) { const int n = (lane >> 3) + 8 * j; const float* s = scr + (8 * c) * 33 + n;
        u32x4 o; o.x = cvt_pk_bf16(s[0 * 33], s[1 * 33]); o.y = cvt_pk_bf16(s[2 * 33], s[3 * 33]); o.z = cvt_pk_bf16(s[4 * 33], s[5 * 33]); o.w = cvt_pk_bf16(s[6 * 33], s[7 * 33]);
        const int f = n0 + n; const int drow = MODE == 0 ? permrow(f) : ((f >> 7) * 256 + (MODE == 2 ? 128 : 0) + permrow(f & 127));
        *(u32x4*)(WT + (size_t)drow * K + k0 + 8 * c) = o; }
    asm volatile("s_waitcnt lgkmcnt(0)" ::: "memory");
}

template <bool SILU>
__device__ __forceinline__ void gemv9_unit(const Ctx& X, const float* c0, int cstride, const float* c8, const float* W, int ldw, int j0, const float* bias, float* out, int ostride) {
    float* sc = (float*)X.lds;
    float* red = sc + 9 * 1024;
    __syncthreads();
    for (int i = X.tid; i < 9 * 1024; i += 512) { const int r = i >> 10, k = i & 1023; float v = r < 8 ? c0[(size_t)r * cstride + k] : c8[k]; if (SILU) v = v * fast_sigmoid(v); sc[i] = v; }
    __syncthreads();
    const int cgi = X.tid & 15, kg = X.tid >> 4;
    const float* wp = W + (size_t)(kg * 32) * ldw + j0 + cgi * 4;
    f32x4 a[9];
#pragma unroll
    for (int r = 0; r < 9; ++r) a[r] = (f32x4){0.f, 0.f, 0.f, 0.f};
#pragma unroll 8
    for (int k = 0; k < 32; ++k) { const f32x4 w = *(const f32x4*)(wp + (size_t)k * ldw);
#pragma unroll
        for (int r = 0; r < 9; ++r) a[r] += w * sc[r * 1024 + kg * 32 + k]; }
#pragma unroll
    for (int r = 0; r < 9; ++r) *(f32x4*)(red + (kg * 9 + r) * 64 + cgi * 4) = a[r];
    __syncthreads();
    for (int o = X.tid; o < 576; o += 512) { const int r = o >> 6, j = o & 63; float sm = bias ? bias[j0 + j] : 0.f;
#pragma unroll 8
        for (int k2 = 0; k2 < 32; ++k2) sm += red[(k2 * 9 + r) * 64 + j];
        out[(size_t)r * ostride + j0 + j] = sm; }
}

__device__ __forceinline__ void ssm_build(const Ctx& X, int g, const float* lam_re, const float* lam_im, const float* log_dt, const float* b_re, const float* b_im,
                                          const float* c_re, const float* c_im, const float* dsk, bf16_t* TC, bf16_t* BS, float* AT) {
    float* PWR = (float*)X.lds;
    float* PWI = PWR + 2 * 64 * 33;
    float* BBR = PWI + 2 * 64 * 33;
    float* BBI = BBR + 2 * 64 * 16;
    float* CCR = BBI + 2 * 64 * 16;
    float* CCI = CCR + 2 * 16 * 64;
    float* KT = CCI + 2 * 16 * 64;
    __syncthreads();
    if (X.tid < 128) {
        const int dir = X.tid >> 6, p = X.tid & 63;
        const float dt = expf(log_dt[dir * 32 + g]);
        const float lr = lam_re[(dir * 32 + g) * 64 + p], li = lam_im[(dir * 32 + g) * 64 + p];
        const float mag = expf(lr * dt); const float ang = li * dt;
        const float ar = mag * cosf(ang), ai = mag * sinf(ang);
        const float nr = ar - 1.0f, den = lr * lr + li * li;
        const float fr_ = (nr * lr + ai * li) / den, fi_ = (ai * lr - nr * li) / den;
        for (int i = 0; i < 16; ++i) { const float br = b_re[((size_t)(dir * 32 + g) * 64 + p) * 16 + i], bi = b_im[((size_t)(dir * 32 + g) * 64 + p) * 16 + i];
            BBR[(dir * 64 + p) * 16 + i] = fr_ * br - fi_ * bi; BBI[(dir * 64 + p) * 16 + i] = fr_ * bi + fi_ * br; }
        float pr = 1.0f, pi = 0.0f;
        for (int e = 0; e <= 32; ++e) { PWR[(dir * 64 + p) * 33 + e] = pr; PWI[(dir * 64 + p) * 33 + e] = pi; const float t = pr * ar - pi * ai; pi = pr * ai + pi * ar; pr = t; }
        AT[((g * 2 + dir) * 64 + p) * 2 + 0] = PWR[(dir * 64 + p) * 33 + 32]; AT[((g * 2 + dir) * 64 + p) * 2 + 1] = PWI[(dir * 64 + p) * 33 + 32];
    }
    for (int i = X.tid; i < 2 * 16 * 64; i += 512) { const int dir = i >> 10, j = (i >> 6) & 15, p = i & 63;
        CCR[i] = c_re[((size_t)(dir * 32 + g) * 16 + j) * 64 + p]; CCI[i] = c_im[((size_t)(dir * 32 + g) * 16 + j) * 64 + p]; }
    __syncthreads();
    for (int o = X.tid; o < 2 * 32 * 16; o += 512) { const int dir = o >> 9, d = (o >> 4) & 31, j = o & 15;
        float acc16[16];
#pragma unroll
        for (int i = 0; i < 16; ++i) acc16[i] = 0.f;
        for (int p = 0; p < 64; ++p) { const float cr = CCR[(dir * 16 + j) * 64 + p], ci = CCI[(dir * 16 + j) * 64 + p], pr = PWR[(dir * 64 + p) * 33 + d], pi = PWI[(dir * 64 + p) * 33 + d];
            const float cwr = cr * pr - ci * pi, cwi = cr * pi + ci * pr;
#pragma unroll
            for (int i = 0; i < 16; ++i) acc16[i] += cwr * BBR[(dir * 64 + p) * 16 + i] - cwi * BBI[(dir * 64 + p) * 16 + i]; }
#pragma unroll
        for (int i = 0; i < 16; ++i) KT[((dir * 32 + d) * 16 + j) * 16 + i] = acc16[i]; }
    __syncthreads();
    if (X.tid < 256) { const int j = X.tid >> 4, i = X.tid & 15; KT[X.tid] += KT[(1 * 32 * 16 + j) * 16 + i] + (i == j ? dsk[g * 16 + j] : 0.f); }
    __syncthreads();
    typedef float f32x2v __attribute__((ext_vector_type(2)));
    bf16_t* tc = TC + (size_t)g * 512 * 768;
    for (int row = X.wave; row < 512; row += 8) { const int t = row >> 4, j = row & 15; unsigned* trow = (unsigned*)(tc + (size_t)row * 768);
#pragma unroll
        for (int c = 0; c < 4; ++c) { const int kap = c * 128 + 2 * X.lane, s_ = kap >> 4, i = kap & 15, dd = t - s_;
            const f32x2v v = *(const f32x2v*)(KT + (((dd >= 0 ? dd : 32 - dd) * 16 + j) * 16 + i));
            trow[kap >> 1] = cvt_pk_bf16(v.x, v.y); }
#pragma unroll
        for (int c = 0; c < 2; ++c) { const int kk = c * 128 + 2 * X.lane, dir = kk >> 7, reim = (kk >> 6) & 1, p = kk & 63, e = dir == 0 ? t + 1 : 32 - t;
            const f32x2v cr = *(const f32x2v*)(CCR + (dir * 16 + j) * 64 + p), ci = *(const f32x2v*)(CCI + (dir * 16 + j) * 64 + p);
            const float pr0 = PWR[(dir * 64 + p) * 33 + e], pi0 = PWI[(dir * 64 + p) * 33 + e], pr1 = PWR[(dir * 64 + p + 1) * 33 + e], pi1 = PWI[(dir * 64 + p + 1) * 33 + e];
            const float v0 = reim == 0 ? (cr.x * pr0 - ci.x * pi0) : -(cr.x * pi0 + ci.x * pr0), v1 = reim == 0 ? (cr.y * pr1 - ci.y * pi1) : -(cr.y * pi1 + ci.y * pr1);
            trow[(512 + kk) >> 1] = cvt_pk_bf16(v0, v1); } }
    bf16_t* bs = BS + (size_t)g * 256 * 512;
    for (int nu = X.wave; nu < 256; nu += 8) { const int dir = nu >> 7, reim = (nu >> 6) & 1, p = nu & 63; unsigned* brow = (unsigned*)(bs + (size_t)nu * 512);
#pragma unroll
        for (int c = 0; c < 4; ++c) { const int kap = c * 128 + 2 * X.lane, s_ = kap >> 4, i = kap & 15, e = dir == 0 ? 31 - s_ : s_;
            const float pr = PWR[(dir * 64 + p) * 33 + e], pi = PWI[(dir * 64 + p) * 33 + e]; const f32x2v br = *(const f32x2v*)(BBR + (dir * 64 + p) * 16 + i), bi = *(const f32x2v*)(BBI + (dir * 64 + p) * 16 + i);
            brow[kap >> 1] = reim == 0 ? cvt_pk_bf16(pr * br.x - pi * bi.x, pr * br.y - pi * bi.y) : cvt_pk_bf16(pr * bi.x + pi * br.x, pr * bi.y + pi * br.y); } }
    __syncthreads();
}

__device__ __forceinline__ void dft_mats(const Ctx& X, bf16_t* W256, bf16_t* CS256) {
    const int gt = X.bx * 512 + X.tid, NT = X.G * 512;
    for (int o = gt; o < 512 * 512; o += NT) { const int nu = o >> 9, kap = o & 511, kb = nu & 255, bp = kap & 255, mm = (kb * bp) & 255;
        const float cs = cospif((float)mm * (1.0f / 128.0f)), sn = sinpif((float)mm * (1.0f / 128.0f));
        float v; if (nu < 256) v = kap < 256 ? cs : sn; else v = kap < 256 ? -sn : cs;
        W256[o] = f2bf(v); }
    for (int o = gt; o < 256 * 512; o += NT) { const int kc = o >> 9, kap = o & 511, cc = kap & 255, mm = (kc * cc) & 255;
        CS256[o] = f2bf(kap < 256 ? cospif((float)mm * (1.0f / 128.0f)) : sinpif((float)mm * (1.0f / 128.0f))); }
}

__device__ __forceinline__ void norm_pass(const Ctx& X, const float* xs, const float* cs, int nrows, const float* gain, const float* modl, int si, bf16_t* HN) {
    for (int r = X.gw; r < nrows; r += X.NGW) {
        const float* row = r < MX ? xs + (size_t)r * D : cs + (size_t)(r - MX) * D;
        const int mb = r < MX ? (r >> 12) : 8;
        const float* sh = modl + (size_t)mb * 9216 + si * 1024; const float* scl = sh + 1024;
        f32x4 v[4]; float s = 0.f;
#pragma unroll
        for (int j = 0; j < 4; ++j) { v[j] = *(const f32x4*)(row + (X.lane + 64 * j) * 4); s += (v[j].x * v[j].x + v[j].y * v[j].y) + (v[j].z * v[j].z + v[j].w * v[j].w); }
        const float rstd = rsqrtf(wave_sum(s) * (1.0f / 1024.0f) + 1e-6f);
#pragma unroll
        for (int j = 0; j < 4; ++j) { const int c = (X.lane + 64 * j) * 4; const f32x4 gn = *(const f32x4*)(gain + c), a = *(const f32x4*)(scl + c), b = *(const f32x4*)(sh + c);
            const f32x4 o = v[j] * rstd * gn * (a + 1.0f) + b; u32x2 w; w.x = cvt_pk_bf16(o.x, o.y); w.y = cvt_pk_bf16(o.z, o.w); *(u32x2*)(HN + (size_t)r * D + c) = w; }
    }
}

__device__ __forceinline__ void norm_pass_bf16(const Ctx& X, const bf16_t* xs, const bf16_t* cs, int nrows, const float* gain, const float* modl, int si, bf16_t* HN) {
    for (int r = X.gw; r < nrows; r += X.NGW) {
        const int mb = r < MX ? (r >> 12) : 8;
        const float* sh = modl + (size_t)mb * 9216 + si * 1024; const float* scl = sh + 1024;
        const bf16_t* rowp = r < MX ? xs + (size_t)r * D : cs + (size_t)(r - MX) * D;
        u32x4 q[2]; float v[2][8]; float s = 0.f;
#pragma unroll
        for (int j = 0; j < 2; ++j) q[j] = *(const u32x4*)(rowp + (X.lane + 64 * j) * 8);
#pragma unroll
        for (int j = 0; j < 2; ++j) {
            v[j][0] = bf2f(q[j].x & 0xffffu); v[j][1] = bf2f(q[j].x >> 16); v[j][2] = bf2f(q[j].y & 0xffffu); v[j][3] = bf2f(q[j].y >> 16);
            v[j][4] = bf2f(q[j].z & 0xffffu); v[j][5] = bf2f(q[j].z >> 16); v[j][6] = bf2f(q[j].w & 0xffffu); v[j][7] = bf2f(q[j].w >> 16);
#pragma unroll
            for (int e = 0; e < 8; ++e) s += v[j][e] * v[j][e]; }
        const float rstd = rsqrtf(wave_sum(s) * (1.0f / 1024.0f) + 1e-6f);
#pragma unroll
        for (int j = 0; j < 2; ++j) { const int c = (X.lane + 64 * j) * 8; float o[8];
#pragma unroll
            for (int h = 0; h < 2; ++h) { const f32x4 gn = *(const f32x4*)(gain + c + 4 * h), a = *(const f32x4*)(scl + c + 4 * h), b = *(const f32x4*)(sh + c + 4 * h);
#pragma unroll
                for (int e = 0; e < 4; ++e) o[4 * h + e] = v[j][4 * h + e] * rstd * gn[e] * (a[e] + 1.0f) + b[e]; }
            u32x4 w; w.x = cvt_pk_bf16(o[0], o[1]); w.y = cvt_pk_bf16(o[2], o[3]); w.z = cvt_pk_bf16(o[4], o[5]); w.w = cvt_pk_bf16(o[6], o[7]); *(u32x4*)(HN + (size_t)r * D + c) = w; }
    }
}

__device__ __forceinline__ void norm_ctx(const Ctx& X, const float* ctx, const float* P, const float* gate8, const float* gain, const float* mod8, int si, bf16_t* HN) {
    const float* sh = mod8 + si * 1024; const float* scl = sh + 1024;
    for (int r = X.gw; r < MC; r += X.NGW) {
        f32x4 v[4]; float s = 0.f;
#pragma unroll
        for (int j = 0; j < 4; ++j) { const int c = (X.lane + 64 * j) * 4; const size_t o = (size_t)r * D + c;
            const f32x4 p = (*(const f32x4*)(P + o) + *(const f32x4*)(P + (size_t)MC * D + o)) + (*(const f32x4*)(P + (size_t)2 * MC * D + o) + *(const f32x4*)(P + (size_t)3 * MC * D + o));
            v[j] = *(const f32x4*)(ctx + o) + *(const f32x4*)(gate8 + c) * 0.5f * p; s += (v[j].x * v[j].x + v[j].y * v[j].y) + (v[j].z * v[j].z + v[j].w * v[j].w); }
        const float rstd = rsqrtf(wave_sum(s) * (1.0f / 1024.0f) + 1e-6f);
#pragma unroll
        for (int j = 0; j < 4; ++j) { const int c = (X.lane + 64 * j) * 4; const f32x4 gn = *(const f32x4*)(gain + c), a = *(const f32x4*)(scl + c), b = *(const f32x4*)(sh + c);
            const f32x4 o = v[j] * rstd * gn * (a + 1.0f) + b; u32x2 w; w.x = cvt_pk_bf16(o.x, o.y); w.y = cvt_pk_bf16(o.z, o.w); *(u32x2*)(HN + (size_t)(MX + r) * D + c) = w; }
    }
}

__device__ __forceinline__ void prep_phase(const Ctx& X, const bf16_t* QKV, const float* qg, const float* kg, bf16_t* QP, bf16_t* KP, bf16_t* VT) {
    bf16_t* vt = (bf16_t*)X.lds;
    const float qgl = qg[X.lane], kgl = kg[X.lane];
    const int f = X.lane & 31; const float invf = exp2f(-(float)(f & 15) * (13.287712379549449f / 16.0f));
    for (int unit = X.bx; unit < MALL / 64; unit += X.G) {
        const int R0 = unit * 64; const bool lat = R0 < MX; const int b = lat ? (R0 >> 12) : ((R0 - MX) >> 8); const int t0 = lat ? (R0 & 4095) : ((R0 - MX) & 255); const int kp0 = lat ? t0 : 4096 + t0;
        __syncthreads();
        for (int rr = 0; rr < 8; ++rr) { const int tl = X.wave * 8 + rr, R = R0 + tl, t = t0 + tl;
            const bf16_t* rowp = QKV + (size_t)R * QKVW;
            const float pos = (f < 16) ? (float)(t >> 6) : (float)(t & 63); const float ang = pos * invf; const float rev = __builtin_amdgcn_fractf(ang * 0.15915494309189535f); const float cs = __builtin_amdgcn_cosf(rev), sn = __builtin_amdgcn_sinf(rev);
            if (lat) {
#pragma unroll
                for (int h = 0; h < 8; ++h) { const float x = bf2f(rowp[h * 64 + X.lane]); const float y = x * rsqrtf(wave_sum(x * x) * (1.0f / 64.0f) + 1e-6f) * qgl; const float pr = __shfl_xor(y, 32);
                    const float o = X.lane < 32 ? (y * cs - pr * sn) : (pr * sn + y * cs); QP[((size_t)R * 8 + h) * 64 + X.lane] = f2bf(o * (0.125f * LOG2E)); } }
#pragma unroll
            for (int h = 0; h < 2; ++h) { const float x = bf2f(rowp[512 + h * 64 + X.lane]); float y = x * rsqrtf(wave_sum(x * x) * (1.0f / 64.0f) + 1e-6f) * kgl;
                if (lat) { const float pr = __shfl_xor(y, 32); y = X.lane < 32 ? (y * cs - pr * sn) : (pr * sn + y * cs); }
                KP[((size_t)(b * 2 + h) * KPL + kp0 + tl) * 64 + X.lane] = f2bf(y);
                vt[(h * 64 + X.lane) * 72 + tl] = rowp[640 + h * 64 + X.lane]; }
        }
        __syncthreads();
        { const int row = X.tid >> 2, ch = X.tid & 3, h = row >> 6, d = row & 63;
            const u32x4 a = *(const u32x4*)(vt + row * 72 + ch * 16), c2 = *(const u32x4*)(vt + row * 72 + ch * 16 + 8);
            bf16_t* dp = VT + ((size_t)(b * 2 + h) * 64 + d) * KPL + kp0 + ch * 16; *(u32x4*)dp = a; *(u32x4*)(dp + 8) = c2; }
    }
    __syncthreads();
}

__device__ __forceinline__ void attn_unit(int b, int qb, int kvh, const bf16_t* __restrict__ QP, const bf16_t* __restrict__ KP, const bf16_t* __restrict__ VT, const float* sink, bf16_t* MIX, unsigned char* ldsb, int tid, int wave, int lane) {
    const int fr = lane & 15, fq = lane >> 4, hq = kvh * 4 + (wave >> 1), q0 = qb * 64 + (wave & 1) * 32;
    bf16x8 qf[2][2];
#pragma unroll
    for (int qt = 0; qt < 2; ++qt)
#pragma unroll
        for (int ks = 0; ks < 2; ++ks) qf[qt][ks] = *(const bf16x8*)(QP + ((size_t)(b * 4096 + q0 + qt * 16 + fr) * 8 + hq) * 64 + ks * 32 + fq * 8);
    const bf16_t* Kb = KP + (size_t)(b * 2 + kvh) * KPL * 64; const bf16_t* Vb = VT + (size_t)(b * 2 + kvh) * 64 * KPL;
    float mrun[2], lrun[2]; f32x4 o[4][2];
    const float sk = sink[hq] * LOG2E;
#pragma unroll
    for (int qt = 0; qt < 2; ++qt) { mrun[qt] = sk; lrun[qt] = fq == 0 ? 1.0f : 0.0f;
#pragma unroll
        for (int dt = 0; dt < 4; ++dt) o[dt][qt] = (f32x4){0.f, 0.f, 0.f, 0.f}; }
    const int first = qb == 0 ? 2 : (qb == 1 ? 1 : 0), lastw = (65 - qb) < 4 ? (65 - qb) : 4, nW = lastw - first + 1, nT = nW + 4;
#define ATT_KS0(j) ((j) < nW ? qb * 64 - 128 + (first + (j)) * 64 : 4096 + ((j) - nW) * 64)
    bf16_t* const lb = (bf16_t*)ldsb; const int lr = tid >> 3, lc = tid & 7;
    u32x4 kreg = *(const u32x4*)(Kb + (size_t)(ATT_KS0(0) + lr) * 64 + lc * 8), vreg = *(const u32x4*)(Vb + (size_t)lr * KPL + ATT_KS0(0) + lc * 8);
    __syncthreads();
    *(u32x4*)(lb + lr * 72 + lc * 8) = kreg; *(u32x4*)(lb + 4608 + lr * 72 + lc * 8) = vreg;
    __syncthreads();
    for (int jt = 0; jt < nT; ++jt) {
        const int ks0 = ATT_KS0(jt); const bool needmask = (jt < nW) && !((ks0 + 63 - q0 <= 128) && (q0 + 31 - ks0 <= 128)); const bf16_t* Kc = lb + (jt & 1) * 9216; const bf16_t* Vc = Kc + 4608;
        if (jt + 1 < nT) { const int kn0 = ATT_KS0(jt + 1); kreg = *(const u32x4*)(Kb + (size_t)(kn0 + lr) * 64 + lc * 8); vreg = *(const u32x4*)(Vb + (size_t)lr * KPL + kn0 + lc * 8); }
        bf16x8 kf[4][2];
#pragma unroll
        for (int kt = 0; kt < 4; ++kt)
#pragma unroll
            for (int ks = 0; ks < 2; ++ks) kf[kt][ks] = *(const bf16x8*)(Kc + (kt * 16 + fr) * 72 + ks * 32 + fq * 8);
        u32x2 vr[4][2][2];
#pragma unroll
        for (int dt = 0; dt < 4; ++dt)
#pragma unroll
            for (int kk = 0; kk < 2; ++kk) { const bf16_t* vp = Vc + (dt * 16 + fr) * 72 + kk * 32 + 4 * fq; vr[dt][kk][0] = *(const u32x2*)vp; vr[dt][kk][1] = *(const u32x2*)(vp + 16); }
        f32x4 s[4][2];
#pragma unroll
        for (int kt = 0; kt < 4; ++kt)
#pragma unroll
            for (int qt = 0; qt < 2; ++qt) { f32x4 a = (f32x4){0.f, 0.f, 0.f, 0.f};
#pragma unroll
                for (int ks = 0; ks < 2; ++ks) a = __builtin_amdgcn_mfma_f32_16x16x32_bf16(kf[kt][ks], qf[qt][ks], a, 0, 0, 0);
                s[kt][qt] = a; }
        bf16x8 pf[2][2];
#pragma unroll
        for (int qt = 0; qt < 2; ++qt) { const int qpos = q0 + qt * 16 + fr; float mx = -3.0e38f;
#pragma unroll
            for (int kt = 0; kt < 4; ++kt)
#pragma unroll
                for (int j = 0; j < 4; ++j) { float v = s[kt][qt][j]; if (needmask) { const int dd = ks0 + kt * 16 + 4 * fq + j - qpos; if (dd > 128 || dd < -128) v = -1.0e30f; s[kt][qt][j] = v; } mx = fmaxf(mx, v); }
            mx = fmaxf(mx, __shfl_xor(mx, 16)); mx = fmaxf(mx, __shfl_xor(mx, 32));
            const float mnew = fmaxf(mrun[qt], mx), alpha = __builtin_amdgcn_exp2f(mrun[qt] - mnew); mrun[qt] = mnew; float ls = 0.f;
#pragma unroll
            for (int kt = 0; kt < 4; ++kt)
#pragma unroll
                for (int j = 0; j < 4; ++j) { const float p = __builtin_amdgcn_exp2f(s[kt][qt][j] - mnew); s[kt][qt][j] = p; ls += p; }
            lrun[qt] = lrun[qt] * alpha + ls;
#pragma unroll
            for (int dt = 0; dt < 4; ++dt) o[dt][qt] *= alpha;
#pragma unroll
            for (int kk = 0; kk < 2; ++kk) { u32x4 w; w.x = cvt_pk_bf16(s[2 * kk][qt][0], s[2 * kk][qt][1]); w.y = cvt_pk_bf16(s[2 * kk][qt][2], s[2 * kk][qt][3]);
                w.z = cvt_pk_bf16(s[2 * kk + 1][qt][0], s[2 * kk + 1][qt][1]); w.w = cvt_pk_bf16(s[2 * kk + 1][qt][2], s[2 * kk + 1][qt][3]); pf[qt][kk] = __builtin_bit_cast(bf16x8, w); } }
#pragma unroll
        for (int dt = 0; dt < 4; ++dt)
#pragma unroll
            for (int kk = 0; kk < 2; ++kk) { u32x4 w; w.x = vr[dt][kk][0].x; w.y = vr[dt][kk][0].y; w.z = vr[dt][kk][1].x; w.w = vr[dt][kk][1].y; const bf16x8 vf = __builtin_bit_cast(bf16x8, w);
#pragma unroll
                for (int qt = 0; qt < 2; ++qt) o[dt][qt] = __builtin_amdgcn_mfma_f32_16x16x32_bf16(vf, pf[qt][kk], o[dt][qt], 0, 0, 0); }
        if (jt + 1 < nT) { bf16_t* Kn = lb + ((jt + 1) & 1) * 9216; *(u32x4*)(Kn + lr * 72 + lc * 8) = kreg; *(u32x4*)(Kn + 4608 + lr * 72 + lc * 8) = vreg; }
        __syncthreads();
    }
#undef ATT_KS0
#pragma unroll
    for (int qt = 0; qt < 2; ++qt) { float l = lrun[qt]; l += __shfl_xor(l, 16); l += __shfl_xor(l, 32); const float inv = 1.0f / l;
        bf16_t* op = MIX + (size_t)(b * 4096 + q0 + qt * 16 + fr) * 1024 + hq * 64 + 4 * fq;
#pragma unroll
        for (int dt = 0; dt < 4; ++dt) { const f32x4 a = o[dt][qt] * inv; u32x2 w; w.x = cvt_pk_bf16(a[0], a[1]); w.y = cvt_pk_bf16(a[2], a[3]); *(u32x2*)(op + dt * 16) = w; } }
}

__device__ __forceinline__ void scan_phase(const Ctx& X, const float* S, const float* AT, bf16_t* A2) {
    if (X.tid >= 128) return;
    const int id = X.bx * 128 + X.tid; if (id >= 8 * 32 * 128) return;
    const int p = id & 63, dir = (id >> 6) & 1, g = (id >> 7) & 31, b = id >> 12;
    const float ar = AT[((g * 2 + dir) * 64 + p) * 2], ai = AT[((g * 2 + dir) * 64 + p) * 2 + 1];
    const float* Sg = S + (size_t)g * A2ROWS * 256 + dir * 128 + p; bf16_t* Hg = A2 + (size_t)g * A2ROWS * A2K + 512 + dir * 128 + p;
    float hr = 0.f, hi = 0.f;
    { float sr[8], si[8];
#pragma unroll
        for (int c = 0; c < 8; ++c) { const int cc = dir == 0 ? c : 7 - c; const size_t n = 1024 + 8 * b + cc; sr[c] = Sg[n * 256]; si[c] = Sg[n * 256 + 64]; }
#pragma unroll
        for (int c = 0; c < 8; ++c) { const float t = ar * hr - ai * hi + sr[c]; hi = ar * hi + ai * hr + si[c]; hr = t; } }
    for (int c0 = 0; c0 < 128; c0 += 16) { float sr[16], si[16];
#pragma unroll
        for (int c = 0; c < 16; ++c) { const int cc = dir == 0 ? c0 + c : 127 - c0 - c; const size_t n = 128 * b + cc; sr[c] = Sg[n * 256]; si[c] = Sg[n * 256 + 64]; }
#pragma unroll
        for (int c = 0; c < 16; ++c) { const int cc = dir == 0 ? c0 + c : 127 - c0 - c; const size_t n = 128 * b + cc;
            Hg[n * A2K] = f2bf(hr); Hg[n * A2K + 64] = f2bf(hi);
            const float t = ar * hr - ai * hi + sr[c]; hi = ar * hi + ai * hr + si[c]; hr = t; } }
}

__device__ __forceinline__ void dft16_phase(const Ctx& X, const bf16_t* HN, bf16_t* GT) {
    bf16_t* tile = (bf16_t*)X.lds;
    float* T16 = (float*)(X.lds + 73728);
    __syncthreads();
    if (X.tid < 16) { T16[X.tid] = cospif((float)X.tid * 0.125f); T16[16 + X.tid] = sinpif((float)X.tid * 0.125f); }
    __syncthreads();
    for (int unit = X.bx; unit < 512; unit += X.G) {
        const int b = unit >> 6, bt = (unit >> 4) & 3, ct = unit & 15, b0 = bt * 64, ch0 = ct * 64;
        const int i = X.tid >> 3, cchunk = X.tid & 7;
        u32x4 xin[16];
#pragma unroll
        for (int a = 0; a < 16; ++a) xin[a] = *(const u32x4*)(HN + (size_t)(b * 4096 + 256 * a + b0 + i) * 1024 + ch0 + cchunk * 8);
        const int bp = b0 + i;
#pragma unroll 1
        for (int kq = 0; kq < 3; ++kq) {
            __syncthreads();
#pragma unroll 1
            for (int kl = 0; kl < 4; ++kl) { const int ka = kq * 4 + kl; if (ka > 8) break;
                const float tang = (float)(bp * ka) * (1.0f / 2048.0f); const float tc = cospif(tang), ts = -sinpif(tang);
                float cw[16], sw[16];
#pragma unroll
                for (int a = 0; a < 16; ++a) { const int m = (a * ka) & 15; cw[a] = T16[m]; sw[a] = T16[16 + m]; }
#pragma unroll
                for (int e = 0; e < 8; ++e) { float re = 0.f, im = 0.f;
#pragma unroll
                    for (int a = 0; a < 16; ++a) { const unsigned wv = xin[a][e >> 1]; const float x = (e & 1) ? bf2f(wv >> 16) : bf2f(wv & 0xffffu); re += x * cw[a]; im -= x * sw[a]; }
                    const float orr = re * tc - im * ts, oi = re * ts + im * tc;
                    tile[((kl * 2 + 0) * 64 + cchunk * 8 + e) * 72 + i] = f2bf(orr); tile[((kl * 2 + 1) * 64 + cchunk * 8 + e) * 72 + i] = f2bf(oi); } }
            __syncthreads();
#pragma unroll
            for (int q = 0; q < 8; ++q) { const int cid = q * 512 + X.tid, row = cid >> 3, c8 = cid & 7, kl = row >> 7, ri = (row >> 6) & 1, ch = row & 63;
                if (kq * 4 + kl > 8) continue;
                const u32x4 v = *(const u32x4*)(tile + row * 72 + c8 * 8);
                *(u32x4*)(GT + ((size_t)(b * 9 + kq * 4 + kl) * 1024 + ch0 + ch) * 512 + ri * 256 + b0 + c8 * 8) = v; }
        }
    }
    __syncthreads();
}


#define XB_TMO      128
#define XB_XCNT(j)  (256  + 64 * (j))
#define XB_XSUB(j)  (1280 + 64 * (j))
#define XB_XGEN(j)  (2304 + 64 * (j))
#define XB_TOP      3328
#define XB_TOPGEN   3392
#define XCD_BAR_WORDS 3456
#define XB_SPIN_CAP (1u << 22)
__device__ __forceinline__ unsigned xb_ld(unsigned* p)              { return __hip_atomic_load(p, __ATOMIC_RELAXED, __HIP_MEMORY_SCOPE_AGENT); }
__device__ __forceinline__ unsigned xb_add(unsigned* p, unsigned v) { return __hip_atomic_fetch_add(p, v, __ATOMIC_RELAXED, __HIP_MEMORY_SCOPE_AGENT); }
__device__ __forceinline__ unsigned xb_xcc_id() { return (unsigned)__builtin_amdgcn_s_getreg((3 << 11) | 20) & 0xFu; }
#define XB_SPIN(cond, bar) do { unsigned _sp = 0; while (cond) { __builtin_amdgcn_s_sleep(1); \
    if ((++_sp & 255u) == 0u) { if (xb_ld(&(bar)[XB_TMO])) break; if (_sp > XB_SPIN_CAP) { atomicAdd(&(bar)[XB_TMO], 1u); break; } } } } while (0)
struct XcdBarrier { unsigned* bar; unsigned x; volatile LAS unsigned* st; };
__device__ __forceinline__ XcdBarrier xcd_barrier_post(unsigned* bar, volatile LAS unsigned* st) {
    XcdBarrier b; b.bar = bar; b.x = xb_xcc_id(); b.st = st;
    if (threadIdx.x == 0) (void)xb_add(&bar[XB_XCNT(b.x)], 1u);
    return b;
}
__device__ __forceinline__ void xcd_barrier_complete(unsigned* bar, unsigned x, unsigned& nloc, unsigned& nx) {
    const unsigned G = gridDim.x * gridDim.y * gridDim.z;
    unsigned sum, cnt, mine, sp = 0u;
    for (;;) {
        sum = 0u; cnt = 0u; mine = 0u;
#pragma unroll
        for (unsigned j = 0; j < 16; ++j) { const unsigned c = xb_ld(&bar[XB_XCNT(j)]); sum += c; cnt += (c > 0u) ? 1u : 0u; mine = (j == x) ? c : mine; }
        if (sum == G) break;
        __builtin_amdgcn_s_sleep(1);
        if ((++sp & 255u) == 0u) { if (xb_ld(&bar[XB_TMO])) break; if (sp > XB_SPIN_CAP) { atomicAdd(&bar[XB_TMO], 1u); break; } }
    }
    nloc = mine > 0u ? mine : 1u; nx = cnt > 0u ? cnt : 1u;
}
__device__ __forceinline__ void xcd_barrier(const XcdBarrier& b) {
    asm volatile("s_waitcnt vmcnt(0)" ::: "memory");
    __syncthreads();
    if (threadIdx.x == 0) {
        unsigned* bar = b.bar;
        __builtin_amdgcn_s_waitcnt(0);
        unsigned nloc = b.st[0], nx = b.st[1];
        if (nloc == 0u) { xcd_barrier_complete(bar, b.x, nloc, nx); b.st[0] = nloc; b.st[1] = nx; }
        const unsigned old = xb_add(&bar[XB_XSUB(b.x)], 1u);
        const unsigned gen = old / nloc;
        if (old + 1u == (gen + 1u) * nloc) {
            __builtin_amdgcn_fence(__ATOMIC_RELEASE, "");
            asm volatile("s_waitcnt vmcnt(0)" ::: "memory");
            const unsigned og = xb_add(&bar[XB_TOP], 1u);
            const unsigned tg = og / nx;
            if (og + 1u == (tg + 1u) * nx) xb_add(&bar[XB_TOPGEN], 1u);
            else XB_SPIN(xb_ld(&bar[XB_TOPGEN]) == tg, bar);
            __builtin_amdgcn_fence(__ATOMIC_ACQUIRE, "");
            xb_add(&bar[XB_XGEN(b.x)], 1u);
            asm volatile("s_waitcnt vmcnt(0)" ::: "memory");
        } else {
            XB_SPIN(xb_ld(&bar[XB_XGEN(b.x)]) == gen, bar);
            __builtin_amdgcn_fence(__ATOMIC_ACQUIRE, "");
            asm volatile("s_waitcnt vmcnt(0)" ::: "memory");
        }
    }
    __syncthreads();
}

struct Args { const float* in[25]; float* out; unsigned char* ws; };

template <bool SWAPD = false, class Epi, class Map>
__device__ __forceinline__ void run_gemm(LAS unsigned char* lds, const bf16_t* A, const bf16_t* Bt, int K, int lda, int ldb, const Map& map, const Epi& E, unsigned gstride = 0) {
    pg8::Gemm g{A, Bt, K, lda, ldb, gstride}; Sched<Map> S{map, (int)gridDim.x, (int)blockIdx.x};
    pg8::gemm_phase<Epi, Sched<Map>, SWAPD>(lds, g, S, E);
}

__global__ void __launch_bounds__(512, 2) fwd_megakernel(Args args) {
    extern __shared__ __attribute__((aligned(16))) unsigned char lds[];
    cg::grid_group grid = cg::this_grid();
    LAS unsigned char* ldsl = (LAS unsigned char*)lds;
    unsigned char* ws = args.ws;
    const float* x_in = args.in[0]; const float* ctx_in = args.in[2]; float* out = args.out;
    float* MOD = (float*)(ws + WS_MOD); float* CTXS = (float*)(ws + WS_CTXS);
    bf16_t* W256 = (bf16_t*)(ws + WS_W256); bf16_t* CS256 = (bf16_t*)(ws + WS_CS256); float* AT = (float*)(ws + WS_AT);
    bf16_t* WINT = (bf16_t*)(ws + WS_WINT); bf16_t* WOUTT = (bf16_t*)(ws + WS_WOUTT); bf16_t* WGLUT = (bf16_t*)(ws + WS_WGLUT); bf16_t* WFT = (bf16_t*)(ws + WS_WFT);
    bf16_t* W13T = (bf16_t*)(ws + WS_W13T); bf16_t* W2T = (bf16_t*)(ws + WS_W2T); bf16_t* TC = (bf16_t*)(ws + WS_TC); bf16_t* BS = (bf16_t*)(ws + WS_BS);
    bf16_t* ACT = (bf16_t*)(ws + WS_ACT); bf16_t* HN = (bf16_t*)(ws + WS_HN);
    bf16_t* QKV = (bf16_t*)(ws + WS_QKV); bf16_t* A2 = (bf16_t*)(ws + WS_A2); float* Sb = (float*)(ws + WS_S); bf16_t* QP = (bf16_t*)(ws + WS_QP);
    bf16_t* KP = (bf16_t*)(ws + WS_KP); bf16_t* VT = (bf16_t*)(ws + WS_VT); bf16_t* Gb = (bf16_t*)(ws + WS_G); bf16_t* MIX = (bf16_t*)(ws + WS_MIX);
    bf16_t* GT = (bf16_t*)(ws + WS_GT); bf16_t* HT = (bf16_t*)(ws + WS_HT); bf16_t* Fb = (bf16_t*)(ws + WS_F);

#ifndef REP_UP
#define REP_UP 1
#endif
#ifndef REP_NORM
#define REP_NORM 1
#endif
#ifndef REP_P0
#define REP_P0 1
#endif
#ifndef REP_SYNC
#define REP_SYNC 1
#endif
#ifndef CG_LO
#define CG_LO 0
#endif
#ifndef CG_HI
#define CG_HI 0
#endif
#define GSYNCN(k) do { if ((k) >= CG_LO && (k) < CG_HI) grid.sync(); else { xcd_barrier(xbar); } } while (0)
#define GSYNC() do { for (int r_ = 0; r_ < REP_SYNC; ++r_) xcd_barrier(xbar); } while (0)
    volatile LAS unsigned* xst = (volatile LAS unsigned*)(ldsl + LDS_BYTES - 64);
    if (threadIdx.x == 0) { xst[0] = 0u; xst[1] = 0u; }
    __syncthreads();
    if (blockIdx.x == 0) for (int i = threadIdx.x; i < XCD_BAR_WORDS; i += 512) __hip_atomic_store((unsigned*)(args.ws + WS_BAR) + i, 0u, __ATOMIC_RELAXED, __HIP_MEMORY_SCOPE_AGENT);
    for (int rep0 = 0; rep0 < REP_P0; ++rep0) {
        const Ctx X = mkctx(lds);
        float* scr = (float*)(lds + X.wave * 16384);
        constexpr int I13 = 16 * 88, I2 = 44 * 32, IIN = 16 * 40, IO = 16 * 32, IG = 8 * 16;
        constexpr int NITEMS = 8 * I13 + 4 * I2 + IIN + IO + IG + IO;
        const bool ssmblk = X.G >= 64 && X.bx >= X.G - 32;
        const int GW = X.G >= 64 ? X.G - 32 : X.G;
        if (!ssmblk) {
        for (int it = X.gw; it < NITEMS; it += GW * 8) {
            int r = it;
            if (r < 8 * I13) { const int which = r / (4 * I13); r %= 4 * I13; const int lh = r / I13; r %= I13;
                if (which == 0) tr_item<1>(args.in[7] + (size_t)lh * D * FF, D, FF, W13T + (size_t)lh * NUP * D, scr, r, X.lane);
                else tr_item<2>(args.in[8] + (size_t)lh * D * FF, D, FF, W13T + (size_t)lh * NUP * D, scr, r, X.lane);
                continue; }
            r -= 8 * I13;
            if (r < 4 * I2) { const int lh = r / I2; r %= I2; tr_item<0>(args.in[9] + (size_t)lh * FF * D, FF, D, W2T + (size_t)lh * D * FF, scr, r, X.lane); continue; }
            r -= 4 * I2;
            if (r < IIN) { tr_item<0>(args.in[10], D, INW, WINT, scr, r, X.lane); continue; } r -= IIN;
            if (r < IO) { tr_item<0>(args.in[23], D, D, WOUTT, scr, r, X.lane); continue; } r -= IO;
            if (r < IG) { tr_item<0>(args.in[22], 512, 512, WGLUT, scr, r, X.lane); continue; } r -= IG;
            tr_item<0>(args.in[24], D, D, WFT, scr, r, X.lane);
        }
        __syncthreads();
        for (int u = X.bx; u < 288; u += GW) { const int l = u / 144, j0 = (u % 144) * 64; gemv9_unit<true>(X, args.in[1], 1024, args.in[3], args.in[4] + (size_t)l * 1024 * 9216, 9216, j0, args.in[5] + (size_t)l * 9216, MOD + (size_t)l * 9 * 9216, 9216); }
        __syncthreads();
        }
        if (ssmblk) ssm_build(X, X.bx - (X.G - 32), args.in[14], args.in[15], args.in[16], args.in[17], args.in[18], args.in[19], args.in[20], args.in[21], TC, BS, AT);
        if (X.G < 64) for (int g2 = X.bx; g2 < 32; g2 += X.G) ssm_build(X, g2, args.in[14], args.in[15], args.in[16], args.in[17], args.in[18], args.in[19], args.in[20], args.in[21], TC, BS, AT);
        dft_mats(X, W256, CS256);
    }
    grid.sync();
    const XcdBarrier xbar = xcd_barrier_post((unsigned*)(args.ws + WS_BAR), xst);

    const float* gains = args.in[6];
    bf16_t* XB = (bf16_t*)out;
    bf16_t* XBC = (bf16_t*)CTXS;
    bf16_t* XB2 = (bf16_t*)(ws + WS_EXTRA);
    const float* MOD0 = MOD; const float* MOD1 = MOD + 9 * 9216;
    for (int rp_ = 0; rp_ < REP_NORM; ++rp_) { norm_pass(mkctx(lds), x_in, ctx_in, MALL, gains + 0 * 1024, MOD0, 0, HN); }
    GSYNCN(0);
    for (int rp_ = 0; rp_ < REP_UP; ++rp_) { run_gemm(ldsl, HN, W13T, 1024, 1024, 1024, MapPlain{MALL / 256, NUP / 256, (size_t)256 * 1024 * 2, (size_t)256 * 1024 * 2}, EpiSwiglu{ACT}); }
    GSYNCN(1);
    run_gemm(ldsl, ACT, W2T, FF, FF, FF, MapDn1{MapPlain{MX / 256, 4, (size_t)256 * FF * 2, (size_t)256 * FF * 2}}, EpiDn1{EpiResidT<true, false>{x_in, ctx_in, XB, XBC, MOD0 + 2 * 1024, 0.5f}, (float*)(ws + WS_EXTRA)});
    GSYNCN(2);
    norm_pass_bf16(mkctx(lds), XB, XBC, MX, gains + 1 * 1024, MOD0, 3, HN);
    norm_ctx(mkctx(lds), ctx_in, (const float*)(ws + WS_EXTRA), MOD0 + 8 * 9216 + 2 * 1024, gains + 1 * 1024, MOD0 + 8 * 9216, 3, HN);
    GSYNCN(3);
    run_gemm(ldsl, HN, WINT, 1024, 1024, 1024, MapPlain{MALL / 256, INW / 256, (size_t)256 * 1024 * 2, (size_t)256 * 1024 * 2}, EpiInproj{QKV, A2});
    GSYNCN(4);
    prep_phase(mkctx(lds), QKV, args.in[11], args.in[12], QP, KP, VT);
    run_gemm(ldsl, A2, BS, 512, A2K, 512, MapS{}, EpiS{Sb});
    GSYNCN(5);
    scan_phase(mkctx(lds), Sb, AT, A2);
    { const Ctx X = mkctx(lds); for (int u = X.bx; u < 1024; u += X.G) attn_unit(u >> 7, (u >> 1) & 63, u & 1, QP, KP, VT, args.in[13], MIX, lds, X.tid, X.wave, X.lane); }
    GSYNCN(6);
    run_gemm(ldsl, A2, TC, A2K, A2K, A2K, MapY{}, EpiY{Gb});
    GSYNCN(7);
    run_gemm(ldsl, Gb, WGLUT, 512, 16, 512, MapPlain{MX / 256, 2, (size_t)256 * 16 * 2, (size_t)256 * 512 * 2}, EpiGlu{Gb, MIX}, (unsigned)MX * 32u);
    GSYNCN(8);
    run_gemm(ldsl, MIX, WOUTT, 1024, 1024, 1024, MapPlain{MX / 256, 4, (size_t)256 * 1024 * 2, (size_t)256 * 1024 * 2}, EpiResidT<false, false>{XB, XB, XB, XB, MOD0 + 5 * 1024, 1.0f});
    GSYNCN(9);
    for (int rp_ = 0; rp_ < REP_NORM; ++rp_) { norm_pass_bf16(mkctx(lds), XB, XBC, MX, gains + 2 * 1024, MOD0, 6, HN); }
    GSYNCN(10);
    for (int rp_ = 0; rp_ < REP_UP; ++rp_) { run_gemm(ldsl, HN, W13T + (size_t)1 * NUP * D, 1024, 1024, 1024, MapPlain{MX / 256, NUP / 256, (size_t)256 * 1024 * 2, (size_t)256 * 1024 * 2}, EpiSwiglu{ACT}); }
    GSYNCN(11);
    run_gemm(ldsl, ACT, W2T + (size_t)1 * D * FF, FF, FF, FF, MapPlain{MX / 256, 4, (size_t)256 * FF * 2, (size_t)256 * FF * 2}, EpiResidT<false, false>{XB, XB, XB, XB, MOD0 + 8 * 1024, 0.5f});
    GSYNCN(12);
    for (int rp_ = 0; rp_ < REP_NORM; ++rp_) { norm_pass_bf16(mkctx(lds), XB, XBC, MX, gains + 3 * 1024, MOD1, 0, HN); }
    GSYNCN(13);
    for (int rp_ = 0; rp_ < REP_UP; ++rp_) { run_gemm(ldsl, HN, W13T + (size_t)2 * NUP * D, 1024, 1024, 1024, MapPlain{MX / 256, NUP / 256, (size_t)256 * 1024 * 2, (size_t)256 * 1024 * 2}, EpiSwiglu{ACT}); }
    GSYNCN(14);
    run_gemm(ldsl, ACT, W2T + (size_t)2 * D * FF, FF, FF, FF, MapPlain{MX / 256, 4, (size_t)256 * FF * 2, (size_t)256 * FF * 2}, EpiResidT<false, false>{XB, XB, XB, XB, MOD1 + 2 * 1024, 0.5f});
    GSYNCN(15);
    for (int rp_ = 0; rp_ < REP_NORM; ++rp_) { norm_pass_bf16(mkctx(lds), XB, XBC, MX, gains + 4 * 1024, MOD1, 3, HN); }
    GSYNCN(16);
    dft16_phase(mkctx(lds), HN, GT);
    GSYNCN(17);
    run_gemm<true>(ldsl, GT, W256, 512, 512, 512, MapPlain{73728 / 256, 2, (size_t)256 * 512 * 2, (size_t)256 * 512 * 2}, EpiDftA{HT});
    GSYNCN(18);
    run_gemm(ldsl, HT, CS256, 512, 2048, 512, MapB{}, EpiF{Fb});
    GSYNCN(19);
    run_gemm(ldsl, Fb, WFT, 1024, 1024, 1024, MapPlain{MX / 256, 4, (size_t)256 * 1024 * 2, (size_t)256 * 1024 * 2}, EpiResidT<false, false>{XB, XB, XB2, XB2, MOD1 + 5 * 1024, 1.0f});
    GSYNCN(20);
    for (int rp_ = 0; rp_ < REP_NORM; ++rp_) { norm_pass_bf16(mkctx(lds), XB2, XB2, MX, gains + 5 * 1024, MOD1, 6, HN); }
    GSYNCN(21);
    for (int rp_ = 0; rp_ < REP_UP; ++rp_) { run_gemm(ldsl, HN, W13T + (size_t)3 * NUP * D, 1024, 1024, 1024, MapPlain{MX / 256, NUP / 256, (size_t)256 * 1024 * 2, (size_t)256 * 1024 * 2}, EpiSwiglu{ACT}); }
    GSYNCN(22);
    run_gemm(ldsl, ACT, W2T + (size_t)3 * D * FF, FF, FF, FF, MapPlain{MX / 256, 4, (size_t)256 * FF * 2, (size_t)256 * FF * 2}, EpiResidT<false, true>{XB2, XB2, out, out, MOD1 + 8 * 1024, 0.5f});
}

extern "C" void kernel_launch(void* const* d_in, const int* in_sizes, int n_in, void* d_out, int out_size, void* d_ws, size_t ws_size, hipStream_t stream) {
    static int grid = 0;
    if (grid == 0) {
        if (n_in != 25 || out_size != MX * D || ws_size < WS_NEED) { fprintf(stderr, "kernel_launch: unexpected problem (n_in %d out %d ws %zu need %zu)\n", n_in, out_size, ws_size, (size_t)WS_NEED); grid = -1; return; }
        int dev = 0, cus = 0, per_cu = 0;
        hipGetDevice(&dev); hipDeviceGetAttribute(&cus, hipDeviceAttributeMultiprocessorCount, dev);
        if (hipFuncSetAttribute((const void*)fwd_megakernel, hipFuncAttributeMaxDynamicSharedMemorySize, LDS_BYTES) != hipSuccess) { fprintf(stderr, "kernel_launch: hipFuncSetAttribute failed\n"); grid = -1; return; }
        if (hipOccupancyMaxActiveBlocksPerMultiprocessor(&per_cu, (const void*)fwd_megakernel, 512, LDS_BYTES) != hipSuccess || per_cu < 1) { fprintf(stderr, "kernel_launch: occupancy query says %d\n", per_cu); per_cu = 1; }
        (void)hipGetLastError();
        grid = cus * 1;
        fprintf(stderr, "kernel_launch: grid %d (cus %d, per_cu %d)\n", grid, cus, per_cu);
    }
    if (grid < 0) return;
    Args a{};
    for (int i = 0; i < 25; ++i) a.in[i] = (const float*)d_in[i];
    a.out = (float*)d_out; a.ws = (unsigned char*)d_ws;
    void* kargs[] = {&a};
    hipError_t e = hipLaunchCooperativeKernel((const void*)fwd_megakernel, dim3(grid), dim3(512), kargs, LDS_BYTES, stream);
    if (e != hipSuccess) fprintf(stderr, "kernel_launch: cooperative launch failed: %s (grid %d)\n", hipGetErrorString(e), grid);
}
```

```cpp
#include <hip/hip_runtime.h>
#include <hip/hip_cooperative_groups.h>
#include <cstdio>
#include <cstdint>
namespace cg = cooperative_groups;

#define LAS __attribute__((address_space(3)))
typedef unsigned short bf16_t;
typedef short bf16x8 __attribute__((ext_vector_type(8)));
typedef float f32x4 __attribute__((ext_vector_type(4)));
typedef unsigned u32x4 __attribute__((ext_vector_type(4)));
typedef unsigned u32x2 __attribute__((ext_vector_type(2)));

constexpr int D = 1024, NB = 8, SEQ = 4096, MX = NB * SEQ, CTXL = 256, MC = NB * CTXL, MALL = MX + MC;
constexpr int FF = 2816, NUP = 2 * FF, INW = 1280, QKVW = 768;
constexpr int KPL = SEQ + CTXL;
constexpr int A2K = 768, A2ROWS = 1280;
constexpr float LOG2E = 1.4426950408889634f;

constexpr size_t MiB = 1u << 20;
constexpr size_t WS_MOD = 0;
constexpr size_t WS_CTXS = 1 * MiB;
constexpr size_t WS_W256 = 9 * MiB;
constexpr size_t WS_CS256 = 9 * MiB + 512 * 1024;
constexpr size_t WS_BAR = 10 * MiB + 512 * 1024;
constexpr size_t WS_AT = 10 * MiB;
constexpr size_t WS_WINT = 11 * MiB;
constexpr size_t WS_WOUTT = 14 * MiB;
constexpr size_t WS_WGLUT = 16 * MiB;
constexpr size_t WS_WFT = 17 * MiB;
constexpr size_t WS_W13T = 19 * MiB;
constexpr size_t WS_W2T = 63 * MiB;
constexpr size_t WS_TC = 85 * MiB;
constexpr size_t WS_BS = 109 * MiB;
constexpr size_t WS_ACT = 117 * MiB;
constexpr size_t WS_HN = 304 * MiB;
constexpr size_t WS_EXTRA = 372 * MiB;
constexpr size_t WS_END = 485 * MiB;
constexpr size_t WS_QKV = WS_ACT;
constexpr size_t WS_A2 = WS_ACT + 52 * MiB;
constexpr size_t WS_S = WS_ACT + 112 * MiB;
constexpr size_t WS_QP = WS_ACT + 152 * MiB;
constexpr size_t WS_KP = WS_EXTRA;
constexpr size_t WS_VT = WS_EXTRA + 9 * MiB;
constexpr size_t WS_G = WS_EXTRA + 18 * MiB;
constexpr size_t WS_MIX = WS_EXTRA + 50 * MiB;
constexpr size_t WS_GT = WS_ACT;
constexpr size_t WS_HT = WS_HN;
constexpr size_t WS_F = WS_ACT;
static_assert(WS_MIX + (size_t)MX * 1024 * 2 <= WS_END + MiB, "mix fits");
constexpr size_t WS_NEED = WS_END + MiB;

constexpr int LDS_BYTES = 147456;

__device__ __forceinline__ unsigned cvt_pk_bf16(float lo, float hi) { unsigned r; asm("v_cvt_pk_bf16_f32 %0, %1, %2" : "=v"(r) : "v"(lo), "v"(hi)); return r; }
__device__ __forceinline__ bf16_t f2bf(float f) { return (bf16_t)(cvt_pk_bf16(f, 0.f) & 0xffffu); }
__device__ __forceinline__ float bf2f(unsigned h) { return __builtin_bit_cast(float, h << 16); }
__device__ __forceinline__ float wave_sum(float v) {
#pragma unroll
    for (int o = 1; o < 64; o <<= 1) v += __shfl_xor(v, o);
    return v;
}
__device__ __forceinline__ float fast_sigmoid(float x) { return __builtin_amdgcn_rcpf(1.0f + __builtin_amdgcn_exp2f(-x * LOG2E)); }
__device__ __forceinline__ float gelu_tanh(float x) { const float u = 0.7978845608028654f * (x + 0.044715f * x * x * x); return x * fast_sigmoid(2.0f * u); }

namespace pg8 {
constexpr int BM = 256, BK = 64, HALF = 128, HTB = HALF * BK * 2, STAGE_BYTES = 8 * HTB, NXCD = 8, WGM = 8;
__device__ __forceinline__ int lds_byte(int r, int c) { const int st = (r >> 4) * 2 + (c >> 5), rr = r & 15, cc = c & 31, ob = rr * 64 + cc * 2; return st * 1024 + (ob ^ (((ob >> 9) & 1) << 5)); }
__device__ __forceinline__ void stage_rc(int b, int& R, int& C) { const int st = b / 1024, sb = b % 1024, swz = sb ^ (((sb >> 9) & 1) << 5); R = (st >> 1) * 16 + swz / 64; C = (st & 1) * 32 + (swz % 64) / 2; }
struct Unit { int pm, pn; size_t aoff, boff; int nt; };
struct Gemm { const bf16_t* A; const bf16_t* Bt; int K, lda, ldb; unsigned gstride; };

template <class Epi, class Sched, bool SWAPD = false>
__device__ __forceinline__ void gemm_phase(LAS unsigned char* lds, const Gemm g, const Sched& S, const Epi& E) {
    int tid_ = threadIdx.x; asm volatile("" : "+v"(tid_));
    const int tid = tid_, wid = __builtin_amdgcn_readfirstlane(tid >> 6), lane = tid & 63, wr = wid >> 2, wc = wid & 3, fr = lane & 15, fq = lane >> 4;
    const int ntK = g.K / BK;
    unsigned voffA[2], voffB[2];
#pragma unroll
    for (int i = 0; i < 2; ++i) { int R, C; stage_rc(tid * 16 + i * 8192, R, C); voffA[i] = g.gstride ? (unsigned)(R * 16 + (C & 15)) * 2u + (unsigned)(C >> 4) * g.gstride : (unsigned)(R * g.lda + C) * 2u; voffB[i] = (unsigned)(R * g.ldb + C) * 2u; }
    const size_t kstep = (size_t)(BK * 2), kstepA = g.gstride ? (size_t)4 * g.gstride : kstep;
    const size_t hstepA = (size_t)HALF * g.lda * 2, hstepB = (size_t)HALF * g.ldb * 2;
    const unsigned ldsw = (unsigned)wid * 1024u;
    const int aoff = lds_byte(wr * 64 + fr, fq * 8), boff = lds_byte(wc * 32 + fr, fq * 8);
#define PG8_SA(b, h) (((b) * 2 + (h)) * HTB)
#define PG8_SB(b, h) ((4 + (b) * 2 + (h)) * HTB)
#define PG8_STAGE(bufoff, gbase, voff) do { _Pragma("unroll") for (int _i = 0; _i < 2; ++_i) \
        __builtin_amdgcn_global_load_lds((const unsigned*)((const char*)(gbase) + (voff)[_i]), (LAS unsigned*)(lds + (bufoff) + ldsw + _i * 8192), 16, 0, 0); } while (0)
#define PG8_LDA(dst, b, h) do { _Pragma("unroll") for (int m = 0; m < 4; ++m) _Pragma("unroll") for (int k = 0; k < 2; ++k) dst[m][k] = *(const LAS bf16x8*)(lds + PG8_SA(b, h) + aoff + m * 2048 + k * 1024); } while (0)
#define PG8_LDB(dst, b, h) do { _Pragma("unroll") for (int n = 0; n < 2; ++n) _Pragma("unroll") for (int k = 0; k < 2; ++k) dst[n][k] = *(const LAS bf16x8*)(lds + PG8_SB(b, h) + boff + n * 2048 + k * 1024); } while (0)
#define PG8_MMA(ai, bj, At, Bt) do { __builtin_amdgcn_s_setprio(1); _Pragma("unroll") for (int m = 0; m < 4; ++m) _Pragma("unroll") for (int n = 0; n < 2; ++n) _Pragma("unroll") for (int k = 0; k < 2; ++k) \
        acc[ai][bj][m][n] = SWAPD ? __builtin_amdgcn_mfma_f32_16x16x32_bf16(At[m][k], Bt[n][k], acc[ai][bj][m][n], 0, 0, 0) : __builtin_amdgcn_mfma_f32_16x16x32_bf16(Bt[n][k], At[m][k], acc[ai][bj][m][n], 0, 0, 0); __builtin_amdgcn_s_setprio(0); } while (0)
#define PG8_WAIT_V(n) asm volatile("s_waitcnt vmcnt(" #n ")" ::: "memory")
#define PG8_WAIT_L(n) asm volatile("s_waitcnt lgkmcnt(" #n ")" ::: "memory")
#define PG8_BAR __builtin_amdgcn_s_barrier()
#define PG8_SCHED __builtin_amdgcn_sched_barrier(0)
    Unit cur, nxt; int ui = 0;
    if (!S.next(0, cur)) return;
    f32x4 acc[2][2][4][2];
#pragma unroll
    for (int a = 0; a < 2; ++a)
#pragma unroll
        for (int b = 0; b < 2; ++b)
#pragma unroll
            for (int m = 0; m < 4; ++m)
#pragma unroll
                for (int n = 0; n < 2; ++n) acc[a][b][m][n] = (f32x4){0.f, 0.f, 0.f, 0.f};
    bf16x8 At[4][2], B0[2][2], B1[2][2];
    const char* cA = (const char*)g.A + cur.aoff; const char* cB = (const char*)g.Bt + cur.boff;
    PG8_STAGE(PG8_SB(0, 0), cB, voffB); PG8_STAGE(PG8_SB(0, 1), cB + hstepB, voffB); PG8_STAGE(PG8_SA(0, 0), cA, voffA); PG8_STAGE(PG8_SA(0, 1), cA + hstepA, voffA);
    if (wr == 1) PG8_BAR;
    PG8_WAIT_V(2); PG8_BAR;
    PG8_STAGE(PG8_SB(1, 0), cB + kstep, voffB); PG8_STAGE(PG8_SA(1, 0), cA + kstepA, voffA); PG8_STAGE(PG8_SB(1, 1), cB + hstepB + kstep, voffB);
    PG8_WAIT_V(6); PG8_BAR;
    for (;;) {
        const bool has_next = S.next(ui + 1, nxt);
        const char* nA = has_next ? (const char*)g.A + nxt.aoff : cA; const char* nB = has_next ? (const char*)g.Bt + nxt.boff : cB;
        const int nt = cur.nt ? cur.nt : ntK;
        for (int t = 0; t < nt; t += 2) {
            const bool last = (t == nt - 2);
            const char* a1 = cA + (size_t)(t + 1) * kstepA;
            const char* a2 = last ? nA : cA + (size_t)(t + 2) * kstepA; const char* b2 = last ? nB : cB + (size_t)(t + 2) * kstep;
            const char* a3 = a2 + kstepA; const char* b3 = b2 + kstep;
            PG8_LDB(B0, 0, 0); PG8_LDB(B1, 0, 1); PG8_SCHED; PG8_LDA(At, 0, 0); PG8_STAGE(PG8_SA(1, 1), a1 + hstepA, voffA);
            PG8_WAIT_V(8); PG8_WAIT_L(0); PG8_BAR; PG8_MMA(0, 0, At, B0); PG8_MMA(0, 1, At, B1); PG8_BAR; PG8_SCHED;
            PG8_LDA(At, 0, 1); PG8_STAGE(PG8_SB(0, 0), b2, voffB); PG8_STAGE(PG8_SB(0, 1), b2 + hstepB, voffB); PG8_STAGE(PG8_SA(0, 0), a2, voffA);
            PG8_WAIT_V(8); PG8_WAIT_L(0); PG8_BAR; PG8_MMA(1, 0, At, B0); PG8_MMA(1, 1, At, B1); PG8_BAR; PG8_SCHED;
            PG8_LDB(B0, 1, 0); PG8_LDB(B1, 1, 1); PG8_SCHED; PG8_LDA(At, 1, 0); PG8_STAGE(PG8_SA(0, 1), a2 + hstepA, voffA);
            PG8_WAIT_V(8); PG8_WAIT_L(0); PG8_BAR; PG8_MMA(0, 0, At, B0); PG8_MMA(0, 1, At, B1); PG8_BAR; PG8_SCHED;
            PG8_LDA(At, 1, 1); PG8_STAGE(PG8_SB(1, 0), b3, voffB); PG8_STAGE(PG8_SB(1, 1), b3 + hstepB, voffB); PG8_STAGE(PG8_SA(1, 0), a3, voffA);
            PG8_WAIT_V(8); PG8_WAIT_L(0); PG8_BAR; PG8_MMA(1, 0, At, B0); PG8_MMA(1, 1, At, B1); PG8_BAR; PG8_SCHED;
        }
        if (wr == 0) PG8_BAR;
        E(acc, cur, wr, wc, fr, fq);
        if (!has_next) break;
#pragma unroll
        for (int a = 0; a < 2; ++a)
#pragma unroll
            for (int b = 0; b < 2; ++b)
#pragma unroll
                for (int m = 0; m < 4; ++m)
#pragma unroll
                    for (int n = 0; n < 2; ++n) acc[a][b][m][n] = (f32x4){0.f, 0.f, 0.f, 0.f};
        cur = nxt; cA = nA; cB = nB; ++ui;
        if (wr == 1) PG8_BAR;
    }
    PG8_WAIT_V(0);
    PG8_BAR;
#undef PG8_SA
#undef PG8_SB
#undef PG8_STAGE
#undef PG8_LDA
#undef PG8_LDB
#undef PG8_MMA
#undef PG8_WAIT_V
#undef PG8_WAIT_L
#undef PG8_BAR
#undef PG8_SCHED
}
}
using pg8::Unit;

struct MapPlain {
    int nM, nN; size_t ta, tb;
    __device__ __forceinline__ int total() const { return nM * nN; }
    __device__ __forceinline__ void operator()(int L, Unit& u) const {
        const int nwg = nM * nN; int wgid = L; { const int q = nwg / 8, r = nwg % 8, xcd = wgid % 8, off = wgid / 8; wgid = (xcd < r ? xcd * (q + 1) : r * (q + 1) + (xcd - r) * q) + off; }
        const int nig = 8 * nN, gid = wgid / nig, fm = gid * 8, gsz = (nM - fm) < 8 ? (nM - fm) : 8;
        u.pm = fm + ((wgid % nig) % gsz); u.pn = (wgid % nig) / gsz; u.aoff = (size_t)u.pm * ta; u.boff = (size_t)u.pn * tb; u.nt = 0;
    }
};
struct MapDn1 {
    MapPlain x;
    __device__ __forceinline__ int total() const { return 512 + 128; }
    __device__ __forceinline__ void operator()(int L, Unit& u) const {
        if (L < 512) { x(L, u); return; }
        const int q = L - 512, tile = q >> 2, sp = q & 3, pmc = tile >> 2, pn = tile & 3, kt0 = sp == 0 ? 0 : (sp == 1 ? 12 : (sp == 2 ? 24 : 34));
        u.pm = 128 + pmc; u.pn = pn | (sp << 4); u.nt = sp < 2 ? 12 : 10;
        u.aoff = ((size_t)u.pm * 256 * FF + kt0 * 64) * 2; u.boff = ((size_t)pn * 256 * FF + kt0 * 64) * 2;
    }
};
struct MapS {
    __device__ __forceinline__ int total() const { return 32 * 5; }
    __device__ __forceinline__ void operator()(int L, Unit& u) const { const int g = L / 5, pml = L % 5; u.pm = g * 5 + pml; u.pn = g; u.aoff = (size_t)u.pm * 256 * A2K * 2; u.boff = (size_t)g * 256 * 512 * 2; u.nt = 0; }
};
struct MapY {
    __device__ __forceinline__ int total() const { return 32 * 8; }
    __device__ __forceinline__ void operator()(int L, Unit& u) const { const int g = L >> 3, pml = (L >> 1) & 3, pnl = L & 1; u.pm = g * 5 + pml; u.pn = g * 2 + pnl; u.aoff = (size_t)u.pm * 256 * A2K * 2; u.boff = ((size_t)g * 512 + pnl * 256) * A2K * 2; u.nt = 0; }
};
struct MapB {
    __device__ __forceinline__ int total() const { return 128 * 4; }
    __device__ __forceinline__ void operator()(int L, Unit& u) const { u.pm = L >> 2; u.pn = L & 3; u.aoff = ((size_t)u.pm * 256 * 2048 + (size_t)u.pn * 512) * 2; u.boff = 0; u.nt = 0; }
};
template <class Map> struct Sched {
    Map map; int G, c;
    __device__ __forceinline__ bool next(int i, Unit& u) const { const long L = (long)i * G + c; if (L >= map.total()) return false; map((int)L, u); return true; }
};

typedef f32x4 Acc[2][2][4][2];
struct EpiSwiglu {
    bf16_t* ACT;
    __device__ __forceinline__ void operator()(const Acc& acc, const Unit& u, int wr, int wc, int fr, int fq) const {
        const int row0 = u.pm * 256 + wr * 64 + fr, h0 = u.pn * 128 + wc * 32 + 8 * fq;
#pragma unroll
        for (int ai = 0; ai < 2; ++ai)
#pragma unroll
            for (int m = 0; m < 4; ++m) { bf16_t* rp = ACT + (size_t)(row0 + ai * 128 + m * 16) * FF + h0; float v[8];
#pragma unroll
                for (int n = 0; n < 2; ++n) { const f32x4 a = acc[ai][0][m][n], b = acc[ai][1][m][n];
                    const f32x4 t = a * (-LOG2E); f32x4 e; e.x = __builtin_amdgcn_exp2f(t.x); e.y = __builtin_amdgcn_exp2f(t.y); e.z = __builtin_amdgcn_exp2f(t.z); e.w = __builtin_amdgcn_exp2f(t.w);
                    const f32x4 d = e + 1.0f; f32x4 r; r.x = __builtin_amdgcn_rcpf(d.x); r.y = __builtin_amdgcn_rcpf(d.y); r.z = __builtin_amdgcn_rcpf(d.z); r.w = __builtin_amdgcn_rcpf(d.w);
                    const f32x4 o = (a * b) * r; v[4 * n + 0] = o.x; v[4 * n + 1] = o.y; v[4 * n + 2] = o.z; v[4 * n + 3] = o.w; }
                u32x4 w; w.x = cvt_pk_bf16(v[0], v[1]); w.y = cvt_pk_bf16(v[2], v[3]); w.z = cvt_pk_bf16(v[4], v[5]); w.w = cvt_pk_bf16(v[6], v[7]); *(u32x4*)rp = w; }
    }
};
template <bool SRC32, bool DST32> struct EpiResidT {
    const void* srcx; const void* srcc; void* dstx; void* dstc; const float* gate; float f;
    __device__ __forceinline__ void operator()(const Acc& acc, const Unit& u, int wr, int wc, int fr, int fq) const {
        const bool isx = u.pm < 128; const int mb = isx ? (u.pm >> 4) : 8;
        const size_t tile0 = (size_t)(isx ? u.pm : u.pm - 128) * 256 * D;
        const float* sp32 = (const float*)(isx ? srcx : srcc) + tile0; const bf16_t* sp16 = (const bf16_t*)(isx ? srcx : srcc) + tile0;
        float* dp32 = (float*)(isx ? dstx : dstc) + tile0; bf16_t* dp16 = (bf16_t*)(isx ? dstx : dstc) + tile0;
        const int r0 = wr * 64 + fr, col0 = u.pn * 256 + wc * 32 + 8 * fq; const float* gp = gate + (size_t)mb * 9216 + col0;
        f32x4 gv[2][2];
#pragma unroll
        for (int bj = 0; bj < 2; ++bj)
#pragma unroll
            for (int n = 0; n < 2; ++n) gv[bj][n] = *(const f32x4*)(gp + bj * 128 + n * 4) * f;
#pragma unroll
        for (int ai = 0; ai < 2; ++ai)
#pragma unroll
            for (int m = 0; m < 4; ++m) { const size_t off = (size_t)(r0 + ai * 128 + m * 16) * D + col0;
#pragma unroll
                for (int bj = 0; bj < 2; ++bj) { const size_t o2 = off + bj * 128; f32x4 s0, s1;
                    if (SRC32) { s0 = *(const f32x4*)(sp32 + o2); s1 = *(const f32x4*)(sp32 + o2 + 4); }
                    else { const u32x4 q = *(const u32x4*)(sp16 + o2); s0 = (f32x4){bf2f(q.x & 0xffffu), bf2f(q.x >> 16), bf2f(q.y & 0xffffu), bf2f(q.y >> 16)}; s1 = (f32x4){bf2f(q.z & 0xffffu), bf2f(q.z >> 16), bf2f(q.w & 0xffffu), bf2f(q.w >> 16)}; }
                    const f32x4 v0 = s0 + gv[bj][0] * acc[ai][bj][m][0], v1 = s1 + gv[bj][1] * acc[ai][bj][m][1];
                    if (DST32) { *(f32x4*)(dp32 + o2) = v0; *(f32x4*)(dp32 + o2 + 4) = v1; }
                    else { u32x4 w; w.x = cvt_pk_bf16(v0.x, v0.y); w.y = cvt_pk_bf16(v0.z, v0.w); w.z = cvt_pk_bf16(v1.x, v1.y); w.w = cvt_pk_bf16(v1.z, v1.w); *(u32x4*)(dp16 + o2) = w; } } }
    }
};
struct EpiDn1 {
    EpiResidT<true, false> R; float* P;
    __device__ __forceinline__ void operator()(const Acc& acc, const Unit& u, int wr, int wc, int fr, int fq) const {
        if (u.pm < 128) { R(acc, u, wr, wc, fr, fq); return; }
        const int sp = u.pn >> 4, pn = u.pn & 15; float* pp = P + ((size_t)sp * MC + (size_t)(u.pm - 128) * 256) * D;
        const int r0 = wr * 64 + fr, col0 = pn * 256 + wc * 32 + 8 * fq;
#pragma unroll
        for (int ai = 0; ai < 2; ++ai)
#pragma unroll
            for (int m = 0; m < 4; ++m) { float* rp = pp + (size_t)(r0 + ai * 128 + m * 16) * D + col0;
#pragma unroll
                for (int bj = 0; bj < 2; ++bj) { *(f32x4*)(rp + bj * 128) = acc[ai][bj][m][0]; *(f32x4*)(rp + bj * 128 + 4) = acc[ai][bj][m][1]; } }
    }
};
struct EpiInproj {
    bf16_t* QKV; bf16_t* A2;
    __device__ __forceinline__ void operator()(const Acc& acc, const Unit& u, int wr, int wc, int fr, int fq) const {
        const int row0 = u.pm * 256 + wr * 64 + fr;
#pragma unroll
        for (int ai = 0; ai < 2; ++ai)
#pragma unroll
            for (int m = 0; m < 4; ++m) { const int row = row0 + ai * 128 + m * 16;
#pragma unroll
                for (int bj = 0; bj < 2; ++bj) { const f32x4 a = acc[ai][bj][m][0], b = acc[ai][bj][m][1];
                    u32x4 w; w.x = cvt_pk_bf16(a[0], a[1]); w.y = cvt_pk_bf16(a[2], a[3]); w.z = cvt_pk_bf16(b[0], b[1]); w.w = cvt_pk_bf16(b[2], b[3]);
                    if (u.pn < 3) { const int col = u.pn * 256 + bj * 128 + wc * 32 + 8 * fq; *(u32x4*)(QKV + (size_t)row * QKVW + col) = w; }
                    else { const int g = (u.pn - 3) * 16 + bj * 8 + wc * 2 + (fq >> 1); *(u32x4*)(A2 + ((size_t)g * A2ROWS + (row >> 5)) * A2K + (row & 31) * 16 + 8 * (fq & 1)) = w; } } }
    }
};
struct EpiS {
    float* S;
    __device__ __forceinline__ void operator()(const Acc& acc, const Unit& u, int wr, int wc, int fr, int fq) const {
        const int row0 = u.pm * 256 + wr * 64 + fr, col0 = wc * 32 + 4 * fq;
#pragma unroll
        for (int ai = 0; ai < 2; ++ai)
#pragma unroll
            for (int m = 0; m < 4; ++m) { float* rp = S + (size_t)(row0 + ai * 128 + m * 16) * 256 + col0;
#pragma unroll
                for (int bj = 0; bj < 2; ++bj)
#pragma unroll
                    for (int n = 0; n < 2; ++n) *(f32x4*)(rp + bj * 128 + n * 16) = acc[ai][bj][m][n]; }
    }
};
struct EpiY {
    bf16_t* G;
    __device__ __forceinline__ void operator()(const Acc& acc, const Unit& u, int wr, int wc, int fr, int fq) const {
        const int g = u.pm / 5, pml = u.pm % 5, pnl = u.pn & 1;
#pragma unroll
        for (int ai = 0; ai < 2; ++ai)
#pragma unroll
            for (int m = 0; m < 4; ++m) { const int nrow = pml * 256 + ai * 128 + wr * 64 + m * 16 + fr;
#pragma unroll
                for (int bj = 0; bj < 2; ++bj)
#pragma unroll
                    for (int n = 0; n < 2; ++n) { const int t = pnl * 16 + bj * 8 + wc * 2 + n; const f32x4 a = acc[ai][bj][m][n];
                        u32x2 w; w.x = cvt_pk_bf16(gelu_tanh(a[0]), gelu_tanh(a[1])); w.y = cvt_pk_bf16(gelu_tanh(a[2]), gelu_tanh(a[3]));
                        *(u32x2*)(G + ((size_t)g * MX + nrow * 32 + t) * 16 + 4 * fq) = w; } }
    }
};
struct EpiGlu {
    const bf16_t* G; bf16_t* MIX;
    __device__ __forceinline__ void operator()(const Acc& acc, const Unit& u, int wr, int wc, int fr, int fq) const {
        const int row0 = u.pm * 256 + wr * 64 + fr, col0 = u.pn * 256 + wc * 32 + 8 * fq;
#pragma unroll
        for (int ai = 0; ai < 2; ++ai)
#pragma unroll
            for (int m = 0; m < 4; ++m) { const int row = row0 + ai * 128 + m * 16;
#pragma unroll
                for (int bj = 0; bj < 2; ++bj) { const int col = col0 + bj * 128; const u32x4 gw = *(const u32x4*)(G + ((size_t)(col >> 4) * MX + row) * 16 + (col & 15)); const f32x4 a = acc[ai][bj][m][0], b = acc[ai][bj][m][1];
                    u32x4 w; w.x = cvt_pk_bf16(bf2f(gw.x & 0xffffu) * fast_sigmoid(a[0]), bf2f(gw.x >> 16) * fast_sigmoid(a[1])); w.y = cvt_pk_bf16(bf2f(gw.y & 0xffffu) * fast_sigmoid(a[2]), bf2f(gw.y >> 16) * fast_sigmoid(a[3]));
                    w.z = cvt_pk_bf16(bf2f(gw.z & 0xffffu) * fast_sigmoid(b[0]), bf2f(gw.z >> 16) * fast_sigmoid(b[1])); w.w = cvt_pk_bf16(bf2f(gw.w & 0xffffu) * fast_sigmoid(b[2]), bf2f(gw.w >> 16) * fast_sigmoid(b[3]));
                    *(u32x4*)(MIX + (size_t)row * 1024 + 512 + col) = w; } }
    }
};
struct EpiDftA {
    bf16_t* HT;
    __device__ __forceinline__ void operator()(const Acc& acc, const Unit& u, int wr, int wc, int fr, int fq) const {
        const int bk = u.pm >> 2, gr = u.pm & 3, b = bk / 9, ka = bk % 9, ri = u.pn; const bool mir = ka >= 1 && ka <= 7; const unsigned sgn = ri ? 0x80008000u : 0u;
#pragma unroll
        for (int ai = 0; ai < 2; ++ai)
#pragma unroll
            for (int m = 0; m < 4; ++m) { const int cc = ai * 128 + wr * 64 + m * 16 + 4 * fq; bf16_t* cp = HT + (size_t)gr * 512 + ri * 256 + cc;
#pragma unroll
                for (int bj = 0; bj < 2; ++bj)
#pragma unroll
                    for (int n = 0; n < 2; ++n) { const f32x4 a = acc[ai][bj][m][n]; const int kb = bj * 128 + wc * 32 + n * 16 + fr;
                        u32x2 w; w.x = cvt_pk_bf16(a[0], a[1]); w.y = cvt_pk_bf16(a[2], a[3]); *(u32x2*)(cp + (size_t)(b * 4096 + ka + 16 * kb) * 2048) = w;
                        if (mir) { u32x2 w2; w2.x = w.x ^ sgn; w2.y = w.y ^ sgn; *(u32x2*)(cp + (size_t)(b * 4096 + (16 - ka) + 16 * (255 - kb)) * 2048) = w2; } } }
    }
};
struct EpiF {
    bf16_t* F;
    __device__ __forceinline__ void operator()(const Acc& acc, const Unit& u, int wr, int wc, int fr, int fq) const {
        const int row0 = u.pm * 256 + wr * 64 + fr, col0 = u.pn * 256 + wc * 32 + 4 * fq;
#pragma unroll
        for (int ai = 0; ai < 2; ++ai)
#pragma unroll
            for (int m = 0; m < 4; ++m) { bf16_t* rp = F + (size_t)(row0 + ai * 128 + m * 16) * 1024 + col0;
#pragma unroll
                for (int bj = 0; bj < 2; ++bj)
#pragma unroll
                    for (int n = 0; n < 2; ++n) { const f32x4 a = acc[ai][bj][m][n] * (1.0f / 1024.0f); u32x2 w; w.x = cvt_pk_bf16(a[0], a[1]); w.y = cvt_pk_bf16(a[2], a[3]); *(u32x2*)(rp + bj * 128 + n * 16) = w; } }
    }
};

struct Ctx { unsigned char* lds; int tid, lane, wave, G, bx, gw, NGW; };
__device__ __forceinline__ Ctx mkctx(unsigned char* lds) {
    Ctx X; int t = threadIdx.x; asm volatile("" : "+v"(t)); X.lds = lds; X.tid = t; X.lane = t & 63; X.wave = __builtin_amdgcn_readfirstlane(t >> 6); X.G = gridDim.x; X.bx = blockIdx.x; X.gw = X.bx * 8 + X.wave; X.NGW = X.G * 8; return X;
}

__device__ __forceinline__ int permrow(int c) { return (c & ~31) + 16 * ((c >> 2) & 1) + 4 * ((c >> 3) & 3) + (c & 3); }
template <int MODE>
__device__ __forceinline__ void tr_item(const float* __restrict__ W, int K, int N, bf16_t* WT, float* scr, int item, int lane) {
    const int nblk = N / 32, kb = item / nblk, nb = item % nblk, k0 = 64 * kb, n0 = 32 * nb;
    float tv[32];
#pragma unroll
    for (int i = 0; i < 32; ++i) tv[i] = W[(size_t)(k0 + 2 * i + (lane >> 5)) * N + n0 + (lane & 31)];
#pragma unroll
    for (int i = 0; i < 32; ++i) scr[(2 * i + (lane >> 5)) * 33 + (lane & 31)] = tv[i];
    asm volatile("s_waitcnt lgkmcnt(0)" ::: "memory");
    const int c = lane & 7;
#pragma unroll
    for (int j = 0; j < 4; ++j) { const int n = (lane >> 3) + 8 * j; const float* s = scr + (8 * c) * 33 + n;
        u32x4 o; o.x = cvt_pk_bf16(s[0 * 33], s[1 * 33]); o.y = cvt_pk_bf16(s[2 * 33], s[3 * 33]); o.z = cvt_pk_bf16(s[4 * 33], s[5 * 33]); o.w = cvt_pk_bf16(s[6 * 33], s[7 * 33]);
        const int f = n0 + n; const int drow = MODE == 0 ? permrow(f) : ((f >> 7) * 256 + (MODE == 2 ? 128 : 0) + permrow(f & 127));
        *(u32x4*)(WT + (size_t)drow * K + k0 + 8 * c) = o; }
    asm volatile("s_waitcnt lgkmcnt(0)" ::: "memory");
}

template <bool SILU>
__device__ __forceinline__ void gemv9_unit(const Ctx& X, const float* c0, int cstride, const float* c8, const float* W, int ldw, int j0, const float* bias, float* out, int ostride) {
    float* sc = (float*)X.lds;
    float* red = sc + 9 * 1024;
    __syncthreads();
    for (int i = X.tid; i < 9 * 1024; i += 512) { const int r = i >> 10, k = i & 1023; float v = r < 8 ? c0[(size_t)r * cstride + k] : c8[k]; if (SILU) v = v * fast_sigmoid(v); sc[i] = v; }
    __syncthreads();
    const int cgi = X.tid & 15, kg = X.tid >> 4;
    const float* wp = W + (size_t)(kg * 32) * ldw + j0 + cgi * 4;
    f32x4 a[9];
#pragma unroll
    for (int r = 0; r < 9; ++r) a[r] = (f32x4){0.f, 0.f, 0.f, 0.f};
#pragma unroll 8
    for (int k = 0; k < 32; ++k) { const f32x4 w = *(const f32x4*)(wp + (size_t)k * ldw);
#pragma unroll
        for (int r = 0; r < 9; ++r) a[r] += w * sc[r * 1024 + kg * 32 + k]; }
#pragma unroll
    for (int r = 0; r < 9; ++r) *(f32x4*)(red + (kg * 9 + r) * 64 + cgi * 4) = a[r];
    __syncthreads();
    for (int o = X.tid; o < 576; o += 512) { const int r = o >> 6, j = o & 63; float sm = bias ? bias[j0 + j] : 0.f;
#pragma unroll 8
        for (int k2 = 0; k2 < 32; ++k2) sm += red[(k2 * 9 + r) * 64 + j];
        out[(size_t)r * ostride + j0 + j] = sm; }
}

__device__ __forceinline__ void ssm_build(const Ctx& X, int g, const float* lam_re, const float* lam_im, const float* log_dt, const float* b_re, const float* b_im,
                                          const float* c_re, const float* c_im, const float* dsk, bf16_t* TC, bf16_t* BS, float* AT) {
    float* PWR = (float*)X.lds;
    float* PWI = PWR + 2 * 64 * 33;
    float* BBR = PWI + 2 * 64 * 33;
    float* BBI = BBR + 2 * 64 * 16;
    float* CCR = BBI + 2 * 64 * 16;
    float* CCI = CCR + 2 * 16 * 64;
    float* KT = CCI + 2 * 16 * 64;
    __syncthreads();
    if (X.tid < 128) {
        const int dir = X.tid >> 6, p = X.tid & 63;
        const float dt = expf(log_dt[dir * 32 + g]);
        const float lr = lam_re[(dir * 32 + g) * 64 + p], li = lam_im[(dir * 32 + g) * 64 + p];
        const float mag = expf(lr * dt); const float ang = li * dt;
        const float ar = mag * cosf(ang), ai = mag * sinf(ang);
        const float nr = ar - 1.0f, den = lr * lr + li * li;
        const float fr_ = (nr * lr + ai * li) / den, fi_ = (ai * lr - nr * li) / den;
        for (int i = 0; i < 16; ++i) { const float br = b_re[((size_t)(dir * 32 + g) * 64 + p) * 16 + i], bi = b_im[((size_t)(dir * 32 + g) * 64 + p) * 16 + i];
            BBR[(dir * 64 + p) * 16 + i] = fr_ * br - fi_ * bi; BBI[(dir * 64 + p) * 16 + i] = fr_ * bi + fi_ * br; }
        float pr = 1.0f, pi = 0.0f;
        for (int e = 0; e <= 32; ++e) { PWR[(dir * 64 + p) * 33 + e] = pr; PWI[(dir * 64 + p) * 33 + e] = pi; const float t = pr * ar - pi * ai; pi = pr * ai + pi * ar; pr = t; }
        AT[((g * 2 + dir) * 64 + p) * 2 + 0] = PWR[(dir * 64 + p) * 33 + 32]; AT[((g * 2 + dir) * 64 + p) * 2 + 1] = PWI[(dir * 64 + p) * 33 + 32];
    }
    for (int i = X.tid; i < 2 * 16 * 64; i += 512) { const int dir = i >> 10, j = (i >> 6) & 15, p = i & 63;
        CCR[i] = c_re[((size_t)(dir * 32 + g) * 16 + j) * 64 + p]; CCI[i] = c_im[((size_t)(dir * 32 + g) * 16 + j) * 64 + p]; }
    __syncthreads();
    for (int o = X.tid; o < 2 * 32 * 16; o += 512) { const int dir = o >> 9, d = (o >> 4) & 31, j = o & 15;
        float acc16[16];
#pragma unroll
        for (int i = 0; i < 16; ++i) acc16[i] = 0.f;
        for (int p = 0; p < 64; ++p) { const float cr = CCR[(dir * 16 + j) * 64 + p], ci = CCI[(dir * 16 + j) * 64 + p], pr = PWR[(dir * 64 + p) * 33 + d], pi = PWI[(dir * 64 + p) * 33 + d];
            const float cwr = cr * pr - ci * pi, cwi = cr * pi + ci * pr;
#pragma unroll
            for (int i = 0; i < 16; ++i) acc16[i] += cwr * BBR[(dir * 64 + p) * 16 + i] - cwi * BBI[(dir * 64 + p) * 16 + i]; }
#pragma unroll
        for (int i = 0; i < 16; ++i) KT[((dir * 32 + d) * 16 + j) * 16 + i] = acc16[i]; }
    __syncthreads();
    if (X.tid < 256) { const int j = X.tid >> 4, i = X.tid & 15; KT[X.tid] += KT[(1 * 32 * 16 + j) * 16 + i] + (i == j ? dsk[g * 16 + j] : 0.f); }
    __syncthreads();
    typedef float f32x2v __attribute__((ext_vector_type(2)));
    bf16_t* tc = TC + (size_t)g * 512 * 768;
    for (int row = X.wave; row < 512; row += 8) { const int t = row >> 4, j = row & 15; unsigned* trow = (unsigned*)(tc + (size_t)row * 768);
#pragma unroll
        for (int c = 0; c < 4; ++c) { const int kap = c * 128 + 2 * X.lane, s_ = kap >> 4, i = kap & 15, dd = t - s_;
            const f32x2v v = *(const f32x2v*)(KT + (((dd >= 0 ? dd : 32 - dd) * 16 + j) * 16 + i));
            trow[kap >> 1] = cvt_pk_bf16(v.x, v.y); }
#pragma unroll
        for (int c = 0; c < 2; ++c) { const int kk = c * 128 + 2 * X.lane, dir = kk >> 7, reim = (kk >> 6) & 1, p = kk & 63, e = dir == 0 ? t + 1 : 32 - t;
            const f32x2v cr = *(const f32x2v*)(CCR + (dir * 16 + j) * 64 + p), ci = *(const f32x2v*)(CCI + (dir * 16 + j) * 64 + p);
            const float pr0 = PWR[(dir * 64 + p) * 33 + e], pi0 = PWI[(dir * 64 + p) * 33 + e], pr1 = PWR[(dir * 64 + p + 1) * 33 + e], pi1 = PWI[(dir * 64 + p + 1) * 33 + e];
            const float v0 = reim == 0 ? (cr.x * pr0 - ci.x * pi0) : -(cr.x * pi0 + ci.x * pr0), v1 = reim == 0 ? (cr.y * pr1 - ci.y * pi1) : -(cr.y * pi1 + ci.y * pr1);
            trow[(512 + kk) >> 1] = cvt_pk_bf16(v0, v1); } }
    bf16_t* bs = BS + (size_t)g * 256 * 512;
    for (int nu = X.wave; nu < 256; nu += 8) { const int dir = nu >> 7, reim = (nu >> 6) & 1, p = nu & 63; unsigned* brow = (unsigned*)(bs + (size_t)nu * 512);
#pragma unroll
        for (int c = 0; c < 4; ++c) { const int kap = c * 128 + 2 * X.lane, s_ = kap >> 4, i = kap & 15, e = dir == 0 ? 31 - s_ : s_;
            const float pr = PWR[(dir * 64 + p) * 33 + e], pi = PWI[(dir * 64 + p) * 33 + e]; const f32x2v br = *(const f32x2v*)(BBR + (dir * 64 + p) * 16 + i), bi = *(const f32x2v*)(BBI + (dir * 64 + p) * 16 + i);
            brow[kap >> 1] = reim == 0 ? cvt_pk_bf16(pr * br.x - pi * bi.x, pr * br.y - pi * bi.y) : cvt_pk_bf16(pr * bi.x + pi * br.x, pr * bi.y + pi * br.y); } }
    __syncthreads();
}

__device__ __forceinline__ void dft_mats(const Ctx& X, bf16_t* W256, bf16_t* CS256) {
    const int gt = X.bx * 512 + X.tid, NT = X.G * 512;
    for (int o = gt; o < 512 * 512; o += NT) { const int nu = o >> 9, kap = o & 511, kb = nu & 255, bp = kap & 255, mm = (kb * bp) & 255;
        const float cs = cospif((float)mm * (1.0f / 128.0f)), sn = sinpif((float)mm * (1.0f / 128.0f));
        float v; if (nu < 256) v = kap < 256 ? cs : sn; else v = kap < 256 ? -sn : cs;
        W256[o] = f2bf(v); }
    for (int o = gt; o < 256 * 512; o += NT) { const int kc = o >> 9, kap = o & 511, cc = kap & 255, mm = (kc * cc) & 255;
        CS256[o] = f2bf(kap < 256 ? cospif((float)mm * (1.0f / 128.0f)) : sinpif((float)mm * (1.0f / 128.0f))); }
}

__device__ __forceinline__ void norm_pass(const Ctx& X, const float* xs, const float* cs, int nrows, const float* gain, const float* modl, int si, bf16_t* HN) {
    for (int r = X.gw; r < nrows; r += X.NGW) {
        const float* row = r < MX ? xs + (size_t)r * D : cs + (size_t)(r - MX) * D;
        const int mb = r < MX ? (r >> 12) : 8;
        const float* sh = modl + (size_t)mb * 9216 + si * 1024; const float* scl = sh + 1024;
        f32x4 v[4]; float s = 0.f;
#pragma unroll
        for (int j = 0; j < 4; ++j) { v[j] = *(const f32x4*)(row + (X.lane + 64 * j) * 4); s += (v[j].x * v[j].x + v[j].y * v[j].y) + (v[j].z * v[j].z + v[j].w * v[j].w); }
        const float rstd = rsqrtf(wave_sum(s) * (1.0f / 1024.0f) + 1e-6f);
#pragma unroll
        for (int j = 0; j < 4; ++j) { const int c = (X.lane + 64 * j) * 4; const f32x4 gn = *(const f32x4*)(gain + c), a = *(const f32x4*)(scl + c), b = *(const f32x4*)(sh + c);
            const f32x4 o = v[j] * rstd * gn * (a + 1.0f) + b; u32x2 w; w.x = cvt_pk_bf16(o.x, o.y); w.y = cvt_pk_bf16(o.z, o.w); *(u32x2*)(HN + (size_t)r * D + c) = w; }
    }
}

__device__ __forceinline__ void norm_pass_bf16(const Ctx& X, const bf16_t* xs, const bf16_t* cs, int nrows, const float* gain, const float* modl, int si, bf16_t* HN) {
    for (int r = X.gw; r < nrows; r += X.NGW) {
        const int mb = r < MX ? (r >> 12) : 8;
        const float* sh = modl + (size_t)mb * 9216 + si * 1024; const float* scl = sh + 1024;
        const bf16_t* rowp = r < MX ? xs + (size_t)r * D : cs + (size_t)(r - MX) * D;
        u32x4 q[2]; float v[2][8]; float s = 0.f;
#pragma unroll
        for (int j = 0; j < 2; ++j) q[j] = *(const u32x4*)(rowp + (X.lane + 64 * j) * 8);
#pragma unroll
        for (int j = 0; j < 2; ++j) {
            v[j][0] = bf2f(q[j].x & 0xffffu); v[j][1] = bf2f(q[j].x >> 16); v[j][2] = bf2f(q[j].y & 0xffffu); v[j][3] = bf2f(q[j].y >> 16);
            v[j][4] = bf2f(q[j].z & 0xffffu); v[j][5] = bf2f(q[j].z >> 16); v[j][6] = bf2f(q[j].w & 0xffffu); v[j][7] = bf2f(q[j].w >> 16);
#pragma unroll
            for (int e = 0; e < 8; ++e) s += v[j][e] * v[j][e]; }
        const float rstd = rsqrtf(wave_sum(s) * (1.0f / 1024.0f) + 1e-6f);
#pragma unroll
        for (int j = 0; j < 2; ++j) { const int c = (X.lane + 64 * j) * 8; float o[8];
#pragma unroll
            for (int h = 0; h < 2; ++h) { const f32x4 gn = *(const f32x4*)(gain + c + 4 * h), a = *(const f32x4*)(scl + c + 4 * h), b = *(const f32x4*)(sh + c + 4 * h);
#pragma unroll
                for (int e = 0; e < 4; ++e) o[4 * h + e] = v[j][4 * h + e] * rstd * gn[e] * (a[e] + 1.0f) + b[e]; }
            u32x4 w; w.x = cvt_pk_bf16(o[0], o[1]); w.y = cvt_pk_bf16(o[2], o[3]); w.z = cvt_pk_bf16(o[4], o[5]); w.w = cvt_pk_bf16(o[6], o[7]); *(u32x4*)(HN + (size_t)r * D + c) = w; }
    }
}

__device__ __forceinline__ void norm_ctx(const Ctx& X, const float* ctx, const float* P, const float* gate8, const float* gain, const float* mod8, int si, bf16_t* HN) {
    const float* sh = mod8 + si * 1024; const float* scl = sh + 1024;
    for (int r = X.gw; r < MC; r += X.NGW) {
        f32x4 v[4]; float s = 0.f;
#pragma unroll
        for (int j = 0; j < 4; ++j) { const int c = (X.lane + 64 * j) * 4; const size_t o = (size_t)r * D + c;
            const f32x4 p = (*(const f32x4*)(P + o) + *(const f32x4*)(P + (size_t)MC * D + o)) + (*(const f32x4*)(P + (size_t)2 * MC * D + o) + *(const f32x4*)(P + (size_t)3 * MC * D + o));
            v[j] = *(const f32x4*)(ctx + o) + *(const f32x4*)(gate8 + c) * 0.5f * p; s += (v[j].x * v[j].x + v[j].y * v[j].y) + (v[j].z * v[j].z + v[j].w * v[j].w); }
        const float rstd = rsqrtf(wave_sum(s) * (1.0f / 1024.0f) + 1e-6f);
#pragma unroll
        for (int j = 0; j < 4; ++j) { const int c = (X.lane + 64 * j) * 4; const f32x4 gn = *(const f32x4*)(gain + c), a = *(const f32x4*)(scl + c), b = *(const f32x4*)(sh + c);
            const f32x4 o = v[j] * rstd * gn * (a + 1.0f) + b; u32x2 w; w.x = cvt_pk_bf16(o.x, o.y); w.y = cvt_pk_bf16(o.z, o.w); *(u32x2*)(HN + (size_t)(MX + r) * D + c) = w; }
    }
}

__device__ __forceinline__ void prep_phase(const Ctx& X, const bf16_t* QKV, const float* qg, const float* kg, bf16_t* QP, bf16_t* KP, bf16_t* VT) {
    bf16_t* vt = (bf16_t*)X.lds;
    const float qgl = qg[X.lane], kgl = kg[X.lane];
    const int f = X.lane & 31; const float invf = exp2f(-(float)(f & 15) * (13.287712379549449f / 16.0f));
    for (int unit = X.bx; unit < MALL / 64; unit += X.G) {
        const int R0 = unit * 64; const bool lat = R0 < MX; const int b = lat ? (R0 >> 12) : ((R0 - MX) >> 8); const int t0 = lat ? (R0 & 4095) : ((R0 - MX) & 255); const int kp0 = lat ? t0 : 4096 + t0;
        __syncthreads();
        for (int rr = 0; rr < 8; ++rr) { const int tl = X.wave * 8 + rr, R = R0 + tl, t = t0 + tl;
            const bf16_t* rowp = QKV + (size_t)R * QKVW;
            const float pos = (f < 16) ? (float)(t >> 6) : (float)(t & 63); const float ang = pos * invf; const float rev = __builtin_amdgcn_fractf(ang * 0.15915494309189535f); const float cs = __builtin_amdgcn_cosf(rev), sn = __builtin_amdgcn_sinf(rev);
            if (lat) {
#pragma unroll
                for (int h = 0; h < 8; ++h) { const float x = bf2f(rowp[h * 64 + X.lane]); const float y = x * rsqrtf(wave_sum(x * x) * (1.0f / 64.0f) + 1e-6f) * qgl; const float pr = __shfl_xor(y, 32);
                    const float o = X.lane < 32 ? (y * cs - pr * sn) : (pr * sn + y * cs); QP[((size_t)R * 8 + h) * 64 + X.lane] = f2bf(o * (0.125f * LOG2E)); } }
#pragma unroll
            for (int h = 0; h < 2; ++h) { const float x = bf2f(rowp[512 + h * 64 + X.lane]); float y = x * rsqrtf(wave_sum(x * x) * (1.0f / 64.0f) + 1e-6f) * kgl;
                if (lat) { const float pr = __shfl_xor(y, 32); y = X.lane < 32 ? (y * cs - pr * sn) : (pr * sn + y * cs); }
                KP[((size_t)(b * 2 + h) * KPL + kp0 + tl) * 64 + X.lane] = f2bf(y);
                vt[(h * 64 + X.lane) * 72 + tl] = rowp[640 + h * 64 + X.lane]; }
        }
        __syncthreads();
        { const int row = X.tid >> 2, ch = X.tid & 3, h = row >> 6, d = row & 63;
            const u32x4 a = *(const u32x4*)(vt + row * 72 + ch * 16), c2 = *(const u32x4*)(vt + row * 72 + ch * 16 + 8);
            bf16_t* dp = VT + ((size_t)(b * 2 + h) * 64 + d) * KPL + kp0 + ch * 16; *(u32x4*)dp = a; *(u32x4*)(dp + 8) = c2; }
    }
    __syncthreads();
}

__device__ __forceinline__ void attn_unit(int b, int qb, int kvh, const bf16_t* __restrict__ QP, const bf16_t* __restrict__ KP, const bf16_t* __restrict__ VT, const float* sink, bf16_t* MIX, unsigned char* ldsb, int tid, int wave, int lane) {
    const int fr = lane & 15, fq = lane >> 4, hq = kvh * 4 + (wave >> 1), q0 = qb * 64 + (wave & 1) * 32;
    bf16x8 qf[2][2];
#pragma unroll
    for (int qt = 0; qt < 2; ++qt)
#pragma unroll
        for (int ks = 0; ks < 2; ++ks) qf[qt][ks] = *(const bf16x8*)(QP + ((size_t)(b * 4096 + q0 + qt * 16 + fr) * 8 + hq) * 64 + ks * 32 + fq * 8);
    const bf16_t* Kb = KP + (size_t)(b * 2 + kvh) * KPL * 64; const bf16_t* Vb = VT + (size_t)(b * 2 + kvh) * 64 * KPL;
    float mrun[2], lrun[2]; f32x4 o[4][2];
    const float sk = sink[hq] * LOG2E;
#pragma unroll
    for (int qt = 0; qt < 2; ++qt) { mrun[qt] = sk; lrun[qt] = fq == 0 ? 1.0f : 0.0f;
#pragma unroll
        for (int dt = 0; dt < 4; ++dt) o[dt][qt] = (f32x4){0.f, 0.f, 0.f, 0.f}; }
    const int first = qb == 0 ? 2 : (qb == 1 ? 1 : 0), lastw = (65 - qb) < 4 ? (65 - qb) : 4, nW = lastw - first + 1, nT = nW + 4;
#define ATT_KS0(j) ((j) < nW ? qb * 64 - 128 + (first + (j)) * 64 : 4096 + ((j) - nW) * 64)
    bf16_t* const lb = (bf16_t*)ldsb; const int lr = tid >> 3, lc = tid & 7;
    u32x4 kreg = *(const u32x4*)(Kb + (size_t)(ATT_KS0(0) + lr) * 64 + lc * 8), vreg = *(const u32x4*)(Vb + (size_t)lr * KPL + ATT_KS0(0) + lc * 8);
    __syncthreads();
    *(u32x4*)(lb + lr * 72 + lc * 8) = kreg; *(u32x4*)(lb + 4608 + lr * 72 + lc * 8) = vreg;
    __syncthreads();
    for (int jt = 0; jt < nT; ++jt) {
        const int ks0 = ATT_KS0(jt); const bool needmask = (jt < nW) && !((ks0 + 63 - q0 <= 128) && (q0 + 31 - ks0 <= 128)); const bf16_t* Kc = lb + (jt & 1) * 9216; const bf16_t* Vc = Kc + 4608;
        if (jt + 1 < nT) { const int kn0 = ATT_KS0(jt + 1); kreg = *(const u32x4*)(Kb + (size_t)(kn0 + lr) * 64 + lc * 8); vreg = *(const u32x4*)(Vb + (size_t)lr * KPL + kn0 + lc * 8); }
        bf16x8 kf[4][2];
#pragma unroll
        for (int kt = 0; kt < 4; ++kt)
#pragma unroll
            for (int ks = 0; ks < 2; ++ks) kf[kt][ks] = *(const bf16x8*)(Kc + (kt * 16 + fr) * 72 + ks * 32 + fq * 8);
        u32x2 vr[4][2][2];
#pragma unroll
        for (int dt = 0; dt < 4; ++dt)
#pragma unroll
            for (int kk = 0; kk < 2; ++kk) { const bf16_t* vp = Vc + (dt * 16 + fr) * 72 + kk * 32 + 4 * fq; vr[dt][kk][0] = *(const u32x2*)vp; vr[dt][kk][1] = *(const u32x2*)(vp + 16); }
        f32x4 s[4][2];
#pragma unroll
        for (int kt = 0; kt < 4; ++kt)
#pragma unroll
            for (int qt = 0; qt < 2; ++qt) { f32x4 a = (f32x4){0.f, 0.f, 0.f, 0.f};
#pragma unroll
                for (int ks = 0; ks < 2; ++ks) a = __builtin_amdgcn_mfma_f32_16x16x32_bf16(kf[kt][ks], qf[qt][ks], a, 0, 0, 0);
                s[kt][qt] = a; }
        bf16x8 pf[2][2];
#pragma unroll
        for (int qt = 0; qt < 2; ++qt) { const int qpos = q0 + qt * 16 + fr; float mx = -3.0e38f;
#pragma unroll
            for (int kt = 0; kt < 4; ++kt)
#pragma unroll
                for (int j = 0; j < 4; ++j) { float v = s[kt][qt][j]; if (needmask) { const int dd = ks0 + kt * 16 + 4 * fq + j - qpos; if (dd > 128 || dd < -128) v = -1.0e30f; s[kt][qt][j] = v; } mx = fmaxf(mx, v); }
            mx = fmaxf(mx, __shfl_xor(mx, 16)); mx = fmaxf(mx, __shfl_xor(mx, 32));
            const float mnew = fmaxf(mrun[qt], mx), alpha = __builtin_amdgcn_exp2f(mrun[qt] - mnew); mrun[qt] = mnew; float ls = 0.f;
#pragma unroll
            for (int kt = 0; kt < 4; ++kt)
#pragma unroll
                for (int j = 0; j < 4; ++j) { const float p = __builtin_amdgcn_exp2f(s[kt][qt][j] - mnew); s[kt][qt][j] = p; ls += p; }
            lrun[qt] = lrun[qt] * alpha + ls;
            if (__builtin_amdgcn_ballot_w64(alpha != 1.0f) != 0ull) {
#pragma unroll
                for (int dt = 0; dt < 4; ++dt) o[dt][qt] *= alpha; }
#pragma unroll
            for (int kk = 0; kk < 2; ++kk) { u32x4 w; w.x = cvt_pk_bf16(s[2 * kk][qt][0], s[2 * kk][qt][1]); w.y = cvt_pk_bf16(s[2 * kk][qt][2], s[2 * kk][qt][3]);
                w.z = cvt_pk_bf16(s[2 * kk + 1][qt][0], s[2 * kk + 1][qt][1]); w.w = cvt_pk_bf16(s[2 * kk + 1][qt][2], s[2 * kk + 1][qt][3]); pf[qt][kk] = __builtin_bit_cast(bf16x8, w); } }
#pragma unroll
        for (int dt = 0; dt < 4; ++dt)
#pragma unroll
            for (int kk = 0; kk < 2; ++kk) { u32x4 w; w.x = vr[dt][kk][0].x; w.y = vr[dt][kk][0].y; w.z = vr[dt][kk][1].x; w.w = vr[dt][kk][1].y; const bf16x8 vf = __builtin_bit_cast(bf16x8, w);
#pragma unroll
                for (int qt = 0; qt < 2; ++qt) o[dt][qt] = __builtin_amdgcn_mfma_f32_16x16x32_bf16(vf, pf[qt][kk], o[dt][qt], 0, 0, 0); }
        if (jt + 1 < nT) { bf16_t* Kn = lb + ((jt + 1) & 1) * 9216; *(u32x4*)(Kn + lr * 72 + lc * 8) = kreg; *(u32x4*)(Kn + 4608 + lr * 72 + lc * 8) = vreg; }
        __syncthreads();
    }
#undef ATT_KS0
#pragma unroll
    for (int qt = 0; qt < 2; ++qt) { float l = lrun[qt]; l += __shfl_xor(l, 16); l += __shfl_xor(l, 32); const float inv = 1.0f / l;
        bf16_t* op = MIX + (size_t)(b * 4096 + q0 + qt * 16 + fr) * 1024 + hq * 64 + 4 * fq;
#pragma unroll
        for (int dt = 0; dt < 4; ++dt) { const f32x4 a = o[dt][qt] * inv; u32x2 w; w.x = cvt_pk_bf16(a[0], a[1]); w.y = cvt_pk_bf16(a[2], a[3]); *(u32x2*)(op + dt * 16) = w; } }
}

__device__ __forceinline__ void scan_phase(const Ctx& X, const float* S, const float* AT, bf16_t* A2) {
    if (X.tid >= 128) return;
    const int id = X.bx * 128 + X.tid; if (id >= 8 * 32 * 128) return;
    const int p = id & 63, dir = (id >> 6) & 1, g = (id >> 7) & 31, b = id >> 12;
    const float ar = AT[((g * 2 + dir) * 64 + p) * 2], ai = AT[((g * 2 + dir) * 64 + p) * 2 + 1];
    const float* Sg = S + (size_t)g * A2ROWS * 256 + dir * 128 + p; bf16_t* Hg = A2 + (size_t)g * A2ROWS * A2K + 512 + dir * 128 + p;
    float hr = 0.f, hi = 0.f;
    { float sr[8], si[8];
#pragma unroll
        for (int c = 0; c < 8; ++c) { const int cc = dir == 0 ? c : 7 - c; const size_t n = 1024 + 8 * b + cc; sr[c] = Sg[n * 256]; si[c] = Sg[n * 256 + 64]; }
#pragma unroll
        for (int c = 0; c < 8; ++c) { const float t = ar * hr - ai * hi + sr[c]; hi = ar * hi + ai * hr + si[c]; hr = t; } }
    for (int c0 = 0; c0 < 128; c0 += 16) { float sr[16], si[16];
#pragma unroll
        for (int c = 0; c < 16; ++c) { const int cc = dir == 0 ? c0 + c : 127 - c0 - c; const size_t n = 128 * b + cc; sr[c] = Sg[n * 256]; si[c] = Sg[n * 256 + 64]; }
#pragma unroll
        for (int c = 0; c < 16; ++c) { const int cc = dir == 0 ? c0 + c : 127 - c0 - c; const size_t n = 128 * b + cc;
            Hg[n * A2K] = f2bf(hr); Hg[n * A2K + 64] = f2bf(hi);
            const float t = ar * hr - ai * hi + sr[c]; hi = ar * hi + ai * hr + si[c]; hr = t; } }
}

__device__ __forceinline__ void dft16_phase(const Ctx& X, const bf16_t* HN, bf16_t* GT) {
    bf16_t* tile = (bf16_t*)X.lds;
    float* T16 = (float*)(X.lds + 73728);
    __syncthreads();
    if (X.tid < 16) { T16[X.tid] = cospif((float)X.tid * 0.125f); T16[16 + X.tid] = sinpif((float)X.tid * 0.125f); }
    __syncthreads();
    for (int unit = X.bx; unit < 512; unit += X.G) {
        const int b = unit >> 6, bt = (unit >> 4) & 3, ct = unit & 15, b0 = bt * 64, ch0 = ct * 64;
        const int i = X.tid >> 3, cchunk = X.tid & 7;
        u32x4 xin[16];
#pragma unroll
        for (int a = 0; a < 16; ++a) xin[a] = *(const u32x4*)(HN + (size_t)(b * 4096 + 256 * a + b0 + i) * 1024 + ch0 + cchunk * 8);
        const int bp = b0 + i;
#pragma unroll 1
        for (int kq = 0; kq < 3; ++kq) {
            __syncthreads();
#pragma unroll 1
            for (int kl = 0; kl < 4; ++kl) { const int ka = kq * 4 + kl; if (ka > 8) break;
                const float tang = (float)(bp * ka) * (1.0f / 2048.0f); const float tc = cospif(tang), ts = -sinpif(tang);
                float cw[16], sw[16];
#pragma unroll
                for (int a = 0; a < 16; ++a) { const int m = (a * ka) & 15; cw[a] = T16[m]; sw[a] = T16[16 + m]; }
#pragma unroll
                for (int e = 0; e < 8; ++e) { float re = 0.f, im = 0.f;
#pragma unroll
                    for (int a = 0; a < 16; ++a) { const unsigned wv = xin[a][e >> 1]; const float x = (e & 1) ? bf2f(wv >> 16) : bf2f(wv & 0xffffu); re += x * cw[a]; im -= x * sw[a]; }
                    const float orr = re * tc - im * ts, oi = re * ts + im * tc;
                    tile[((kl * 2 + 0) * 64 + cchunk * 8 + e) * 72 + i] = f2bf(orr); tile[((kl * 2 + 1) * 64 + cchunk * 8 + e) * 72 + i] = f2bf(oi); } }
            __syncthreads();
#pragma unroll
            for (int q = 0; q < 8; ++q) { const int cid = q * 512 + X.tid, row = cid >> 3, c8 = cid & 7, kl = row >> 7, ri = (row >> 6) & 1, ch = row & 63;
                if (kq * 4 + kl > 8) continue;
                const u32x4 v = *(const u32x4*)(tile + row * 72 + c8 * 8);
                *(u32x4*)(GT + ((size_t)(b * 9 + kq * 4 + kl) * 1024 + ch0 + ch) * 512 + ri * 256 + b0 + c8 * 8) = v; }
        }
    }
    __syncthreads();
}


#define XB_TMO      128
#define XB_XCNT(j)  (256  + 64 * (j))
#define XB_XSUB(j)  (1280 + 64 * (j))
#define XB_XGEN(j)  (2304 + 64 * (j))
#define XB_TOP      3328
#define XB_TOPGEN   3392
#define XCD_BAR_WORDS 3456
#define XB_SPIN_CAP (1u << 22)
__device__ __forceinline__ unsigned xb_ld(unsigned* p)              { return __hip_atomic_load(p, __ATOMIC_RELAXED, __HIP_MEMORY_SCOPE_AGENT); }
__device__ __forceinline__ unsigned xb_add(unsigned* p, unsigned v) { return __hip_atomic_fetch_add(p, v, __ATOMIC_RELAXED, __HIP_MEMORY_SCOPE_AGENT); }
__device__ __forceinline__ unsigned xb_xcc_id() { return (unsigned)__builtin_amdgcn_s_getreg((3 << 11) | 20) & 0xFu; }
#define XB_SPIN(cond, bar) do { unsigned _sp = 0; while (cond) { __builtin_amdgcn_s_sleep(1); \
    if ((++_sp & 255u) == 0u) { if (xb_ld(&(bar)[XB_TMO])) break; if (_sp > XB_SPIN_CAP) { atomicAdd(&(bar)[XB_TMO], 1u); break; } } } } while (0)
struct XcdBarrier { unsigned* bar; unsigned x; volatile LAS unsigned* st; };
__device__ __forceinline__ XcdBarrier xcd_barrier_post(unsigned* bar, volatile LAS unsigned* st) {
    XcdBarrier b; b.bar = bar; b.x = xb_xcc_id(); b.st = st;
    if (threadIdx.x == 0) (void)xb_add(&bar[XB_XCNT(b.x)], 1u);
    return b;
}
__device__ __forceinline__ void xcd_barrier_complete(unsigned* bar, unsigned x, unsigned& nloc, unsigned& nx) {
    const unsigned G = gridDim.x * gridDim.y * gridDim.z;
    unsigned sum, cnt, mine, sp = 0u;
    for (;;) {
        sum = 0u; cnt = 0u; mine = 0u;
#pragma unroll
        for (unsigned j = 0; j < 16; ++j) { const unsigned c = xb_ld(&bar[XB_XCNT(j)]); sum += c; cnt += (c > 0u) ? 1u : 0u; mine = (j == x) ? c : mine; }
        if (sum == G) break;
        __builtin_amdgcn_s_sleep(1);
        if ((++sp & 255u) == 0u) { if (xb_ld(&bar[XB_TMO])) break; if (sp > XB_SPIN_CAP) { atomicAdd(&bar[XB_TMO], 1u); break; } }
    }
    nloc = mine > 0u ? mine : 1u; nx = cnt > 0u ? cnt : 1u;
}
__device__ __forceinline__ void xcd_barrier(const XcdBarrier& b) {
    asm volatile("s_waitcnt vmcnt(0)" ::: "memory");
    __syncthreads();
    if (threadIdx.x == 0) {
        unsigned* bar = b.bar;
        __builtin_amdgcn_s_waitcnt(0);
        unsigned nloc = b.st[0], nx = b.st[1];
        if (nloc == 0u) { xcd_barrier_complete(bar, b.x, nloc, nx); b.st[0] = nloc; b.st[1] = nx; }
        const unsigned old = xb_add(&bar[XB_XSUB(b.x)], 1u);
        const unsigned gen = old / nloc;
        if (old + 1u == (gen + 1u) * nloc) {
            __builtin_amdgcn_fence(__ATOMIC_RELEASE, "");
            asm volatile("s_waitcnt vmcnt(0)" ::: "memory");
            const unsigned og = xb_add(&bar[XB_TOP], 1u);
            const unsigned tg = og / nx;
            if (og + 1u == (tg + 1u) * nx) xb_add(&bar[XB_TOPGEN], 1u);
            else XB_SPIN(xb_ld(&bar[XB_TOPGEN]) == tg, bar);
            __builtin_amdgcn_fence(__ATOMIC_ACQUIRE, "");
            xb_add(&bar[XB_XGEN(b.x)], 1u);
            asm volatile("s_waitcnt vmcnt(0)" ::: "memory");
        } else {
            XB_SPIN(xb_ld(&bar[XB_XGEN(b.x)]) == gen, bar);
            __builtin_amdgcn_fence(__ATOMIC_ACQUIRE, "");
            asm volatile("s_waitcnt vmcnt(0)" ::: "memory");
        }
    }
    __syncthreads();
}

struct Args { const float* in[25]; float* out; unsigned char* ws; };

template <bool SWAPD = false, class Epi, class Map>
__device__ __forceinline__ void run_gemm(LAS unsigned char* lds, const bf16_t* A, const bf16_t* Bt, int K, int lda, int ldb, const Map& map, const Epi& E, unsigned gstride = 0) {
    pg8::Gemm g{A, Bt, K, lda, ldb, gstride}; Sched<Map> S{map, (int)gridDim.x, (int)blockIdx.x};
    pg8::gemm_phase<Epi, Sched<Map>, SWAPD>(lds, g, S, E);
}

__global__ void __launch_bounds__(512, 2) fwd_megakernel(Args args) {
    extern __shared__ __attribute__((aligned(16))) unsigned char lds[];
    cg::grid_group grid = cg::this_grid();
    LAS unsigned char* ldsl = (LAS unsigned char*)lds;
    unsigned char* ws = args.ws;
    const float* x_in = args.in[0]; const float* ctx_in = args.in[2]; float* out = args.out;
    float* MOD = (float*)(ws + WS_MOD); float* CTXS = (float*)(ws + WS_CTXS);
    bf16_t* W256 = (bf16_t*)(ws + WS_W256); bf16_t* CS256 = (bf16_t*)(ws + WS_CS256); float* AT = (float*)(ws + WS_AT);
    bf16_t* WINT = (bf16_t*)(ws + WS_WINT); bf16_t* WOUTT = (bf16_t*)(ws + WS_WOUTT); bf16_t* WGLUT = (bf16_t*)(ws + WS_WGLUT); bf16_t* WFT = (bf16_t*)(ws + WS_WFT);
    bf16_t* W13T = (bf16_t*)(ws + WS_W13T); bf16_t* W2T = (bf16_t*)(ws + WS_W2T); bf16_t* TC = (bf16_t*)(ws + WS_TC); bf16_t* BS = (bf16_t*)(ws + WS_BS);
    bf16_t* ACT = (bf16_t*)(ws + WS_ACT); bf16_t* HN = (bf16_t*)(ws + WS_HN);
    bf16_t* QKV = (bf16_t*)(ws + WS_QKV); bf16_t* A2 = (bf16_t*)(ws + WS_A2); float* Sb = (float*)(ws + WS_S); bf16_t* QP = (bf16_t*)(ws + WS_QP);
    bf16_t* KP = (bf16_t*)(ws + WS_KP); bf16_t* VT = (bf16_t*)(ws + WS_VT); bf16_t* Gb = (bf16_t*)(ws + WS_G); bf16_t* MIX = (bf16_t*)(ws + WS_MIX);
    bf16_t* GT = (bf16_t*)(ws + WS_GT); bf16_t* HT = (bf16_t*)(ws + WS_HT); bf16_t* Fb = (bf16_t*)(ws + WS_F);

#ifndef REP_UP
#define REP_UP 1
#endif
#ifndef REP_NORM
#define REP_NORM 1
#endif
#ifndef REP_P0
#define REP_P0 1
#endif
#ifndef REP_SYNC
#define REP_SYNC 1
#endif
#ifndef CG_LO
#define CG_LO 0
#endif
#ifndef CG_HI
#define CG_HI 0
#endif
#define GSYNCN(k) do { if ((k) >= CG_LO && (k) < CG_HI) grid.sync(); else { xcd_barrier(xbar); } } while (0)
#define GSYNC() do { for (int r_ = 0; r_ < REP_SYNC; ++r_) xcd_barrier(xbar); } while (0)
    volatile LAS unsigned* xst = (volatile LAS unsigned*)(ldsl + LDS_BYTES - 64);
    if (threadIdx.x == 0) { xst[0] = 0u; xst[1] = 0u; }
    __syncthreads();
    if (blockIdx.x == 0) for (int i = threadIdx.x; i < XCD_BAR_WORDS; i += 512) __hip_atomic_store((unsigned*)(args.ws + WS_BAR) + i, 0u, __ATOMIC_RELAXED, __HIP_MEMORY_SCOPE_AGENT);
    for (int rep0 = 0; rep0 < REP_P0; ++rep0) {
        const Ctx X = mkctx(lds);
        float* scr = (float*)(lds + X.wave * 16384);
        constexpr int I13 = 16 * 88, I2 = 44 * 32, IIN = 16 * 40, IO = 16 * 32, IG = 8 * 16;
        constexpr int NITEMS = 8 * I13 + 4 * I2 + IIN + IO + IG + IO;
        const bool ssmblk = X.G >= 64 && X.bx >= X.G - 32;
        const int GW = X.G >= 64 ? X.G - 32 : X.G;
        if (!ssmblk) {
        for (int it = X.gw; it < NITEMS; it += GW * 8) {
            int r = it;
            if (r < 8 * I13) { const int which = r / (4 * I13); r %= 4 * I13; const int lh = r / I13; r %= I13;
                if (which == 0) tr_item<1>(args.in[7] + (size_t)lh * D * FF, D, FF, W13T + (size_t)lh * NUP * D, scr, r, X.lane);
                else tr_item<2>(args.in[8] + (size_t)lh * D * FF, D, FF, W13T + (size_t)lh * NUP * D, scr, r, X.lane);
                continue; }
            r -= 8 * I13;
            if (r < 4 * I2) { const int lh = r / I2; r %= I2; tr_item<0>(args.in[9] + (size_t)lh * FF * D, FF, D, W2T + (size_t)lh * D * FF, scr, r, X.lane); continue; }
            r -= 4 * I2;
            if (r < IIN) { tr_item<0>(args.in[10], D, INW, WINT, scr, r, X.lane); continue; } r -= IIN;
            if (r < IO) { tr_item<0>(args.in[23], D, D, WOUTT, scr, r, X.lane); continue; } r -= IO;
            if (r < IG) { tr_item<0>(args.in[22], 512, 512, WGLUT, scr, r, X.lane); continue; } r -= IG;
            tr_item<0>(args.in[24], D, D, WFT, scr, r, X.lane);
        }
        __syncthreads();
        for (int u = X.bx; u < 288; u += GW) { const int l = u / 144, j0 = (u % 144) * 64; gemv9_unit<true>(X, args.in[1], 1024, args.in[3], args.in[4] + (size_t)l * 1024 * 9216, 9216, j0, args.in[5] + (size_t)l * 9216, MOD + (size_t)l * 9 * 9216, 9216); }
        __syncthreads();
        }
        if (ssmblk) ssm_build(X, X.bx - (X.G - 32), args.in[14], args.in[15], args.in[16], args.in[17], args.in[18], args.in[19], args.in[20], args.in[21], TC, BS, AT);
        if (X.G < 64) for (int g2 = X.bx; g2 < 32; g2 += X.G) ssm_build(X, g2, args.in[14], args.in[15], args.in[16], args.in[17], args.in[18], args.in[19], args.in[20], args.in[21], TC, BS, AT);
        dft_mats(X, W256, CS256);
    }
    grid.sync();
    const XcdBarrier xbar = xcd_barrier_post((unsigned*)(args.ws + WS_BAR), xst);

    const float* gains = args.in[6];
    bf16_t* XB = (bf16_t*)out;
    bf16_t* XBC = (bf16_t*)CTXS;
    bf16_t* XB2 = (bf16_t*)(ws + WS_EXTRA);
    const float* MOD0 = MOD; const float* MOD1 = MOD + 9 * 9216;
    for (int rp_ = 0; rp_ < REP_NORM; ++rp_) { norm_pass(mkctx(lds), x_in, ctx_in, MALL, gains + 0 * 1024, MOD0, 0, HN); }
    GSYNCN(0);
    for (int rp_ = 0; rp_ < REP_UP; ++rp_) { run_gemm(ldsl, HN, W13T, 1024, 1024, 1024, MapPlain{MALL / 256, NUP / 256, (size_t)256 * 1024 * 2, (size_t)256 * 1024 * 2}, EpiSwiglu{ACT}); }
    GSYNCN(1);
    run_gemm(ldsl, ACT, W2T, FF, FF, FF, MapDn1{MapPlain{MX / 256, 4, (size_t)256 * FF * 2, (size_t)256 * FF * 2}}, EpiDn1{EpiResidT<true, false>{x_in, ctx_in, XB, XBC, MOD0 + 2 * 1024, 0.5f}, (float*)(ws + WS_EXTRA)});
    GSYNCN(2);
    norm_pass_bf16(mkctx(lds), XB, XBC, MX, gains + 1 * 1024, MOD0, 3, HN);
    norm_ctx(mkctx(lds), ctx_in, (const float*)(ws + WS_EXTRA), MOD0 + 8 * 9216 + 2 * 1024, gains + 1 * 1024, MOD0 + 8 * 9216, 3, HN);
    GSYNCN(3);
    run_gemm(ldsl, HN, WINT, 1024, 1024, 1024, MapPlain{MALL / 256, INW / 256, (size_t)256 * 1024 * 2, (size_t)256 * 1024 * 2}, EpiInproj{QKV, A2});
    GSYNCN(4);
    prep_phase(mkctx(lds), QKV, args.in[11], args.in[12], QP, KP, VT);
    run_gemm(ldsl, A2, BS, 512, A2K, 512, MapS{}, EpiS{Sb});
    GSYNCN(5);
    scan_phase(mkctx(lds), Sb, AT, A2);
    { const Ctx X = mkctx(lds); for (int u = X.bx; u < 1024; u += X.G) attn_unit(u >> 7, (u >> 1) & 63, u & 1, QP, KP, VT, args.in[13], MIX, lds, X.tid, X.wave, X.lane); }
    GSYNCN(6);
    run_gemm(ldsl, A2, TC, A2K, A2K, A2K, MapY{}, EpiY{Gb});
    GSYNCN(7);
    run_gemm(ldsl, Gb, WGLUT, 512, 16, 512, MapPlain{MX / 256, 2, (size_t)256 * 16 * 2, (size_t)256 * 512 * 2}, EpiGlu{Gb, MIX}, (unsigned)MX * 32u);
    GSYNCN(8);
    run_gemm(ldsl, MIX, WOUTT, 1024, 1024, 1024, MapPlain{MX / 256, 4, (size_t)256 * 1024 * 2, (size_t)256 * 1024 * 2}, EpiResidT<false, false>{XB, XB, XB, XB, MOD0 + 5 * 1024, 1.0f});
    GSYNCN(9);
    for (int rp_ = 0; rp_ < REP_NORM; ++rp_) { norm_pass_bf16(mkctx(lds), XB, XBC, MX, gains + 2 * 1024, MOD0, 6, HN); }
    GSYNCN(10);
    for (int rp_ = 0; rp_ < REP_UP; ++rp_) { run_gemm(ldsl, HN, W13T + (size_t)1 * NUP * D, 1024, 1024, 1024, MapPlain{MX / 256, NUP / 256, (size_t)256 * 1024 * 2, (size_t)256 * 1024 * 2}, EpiSwiglu{ACT}); }
    GSYNCN(11);
    run_gemm(ldsl, ACT, W2T + (size_t)1 * D * FF, FF, FF, FF, MapPlain{MX / 256, 4, (size_t)256 * FF * 2, (size_t)256 * FF * 2}, EpiResidT<false, false>{XB, XB, XB, XB, MOD0 + 8 * 1024, 0.5f});
    GSYNCN(12);
    for (int rp_ = 0; rp_ < REP_NORM; ++rp_) { norm_pass_bf16(mkctx(lds), XB, XBC, MX, gains + 3 * 1024, MOD1, 0, HN); }
    GSYNCN(13);
    for (int rp_ = 0; rp_ < REP_UP; ++rp_) { run_gemm(ldsl, HN, W13T + (size_t)2 * NUP * D, 1024, 1024, 1024, MapPlain{MX / 256, NUP / 256, (size_t)256 * 1024 * 2, (size_t)256 * 1024 * 2}, EpiSwiglu{ACT}); }
    GSYNCN(14);
    run_gemm(ldsl, ACT, W2T + (size_t)2 * D * FF, FF, FF, FF, MapPlain{MX / 256, 4, (size_t)256 * FF * 2, (size_t)256 * FF * 2}, EpiResidT<false, false>{XB, XB, XB, XB, MOD1 + 2 * 1024, 0.5f});
    GSYNCN(15);
    for (int rp_ = 0; rp_ < REP_NORM; ++rp_) { norm_pass_bf16(mkctx(lds), XB, XBC, MX, gains + 4 * 1024, MOD1, 3, HN); }
    GSYNCN(16);
    dft16_phase(mkctx(lds), HN, GT);
    GSYNCN(17);
    run_gemm<true>(ldsl, GT, W256, 512, 512, 512, MapPlain{73728 / 256, 2, (size_t)256 * 512 * 2, (size_t)256 * 512 * 2}, EpiDftA{HT});
    GSYNCN(18);
    run_gemm(ldsl, HT, CS256, 512, 2048, 512, MapB{}, EpiF{Fb});
    GSYNCN(19);
    run_gemm(ldsl, Fb, WFT, 1024, 1024, 1024, MapPlain{MX / 256, 4, (size_t)256 * 1024 * 2, (size_t)256 * 1024 * 2}, EpiResidT<false, false>{XB, XB, XB2, XB2, MOD1 + 5 * 1024, 1.0f});
    GSYNCN(20);
    for (int rp_ = 0; rp_ < REP_NORM; ++rp_) { norm_pass_bf16(mkctx(lds), XB2, XB2, MX, gains + 5 * 1024, MOD1, 6, HN); }
    GSYNCN(21);
    for (int rp_ = 0; rp_ < REP_UP; ++rp_) { run_gemm(ldsl, HN, W13T + (size_t)3 * NUP * D, 1024, 1024, 1024, MapPlain{MX / 256, NUP / 256, (size_t)256 * 1024 * 2, (size_t)256 * 1024 * 2}, EpiSwiglu{ACT}); }
    GSYNCN(22);
    run_gemm(ldsl, ACT, W2T + (size_t)3 * D * FF, FF, FF, FF, MapPlain{MX / 256, 4, (size_t)256 * FF * 2, (size_t)256 * FF * 2}, EpiResidT<false, true>{XB2, XB2, out, out, MOD1 + 8 * 1024, 0.5f});
}

extern "C" void kernel_launch(void* const* d_in, const int* in_sizes, int n_in, void* d_out, int out_size, void* d_ws, size_t ws_size, hipStream_t stream) {
    static int grid = 0;
    if (grid == 0) {
        if (n_in != 25 || out_size != MX * D || ws_size < WS_NEED) { fprintf(stderr, "kernel_launch: unexpected problem (n_in %d out %d ws %zu need %zu)\n", n_in, out_size, ws_size, (size_t)WS_NEED); grid = -1; return; }
        int dev = 0, cus = 0, per_cu = 0;
        hipGetDevice(&dev); hipDeviceGetAttribute(&cus, hipDeviceAttributeMultiprocessorCount, dev);
        if (hipFuncSetAttribute((const void*)fwd_megakernel, hipFuncAttributeMaxDynamicSharedMemorySize, LDS_BYTES) != hipSuccess) { fprintf(stderr, "kernel_launch: hipFuncSetAttribute failed\n"); grid = -1; return; }
        if (hipOccupancyMaxActiveBlocksPerMultiprocessor(&per_cu, (const void*)fwd_megakernel, 512, LDS_BYTES) != hipSuccess || per_cu < 1) { fprintf(stderr, "kernel_launch: occupancy query says %d\n", per_cu); per_cu = 1; }
        (void)hipGetLastError();
        grid = cus * 1;
        fprintf(stderr, "kernel_launch: grid %d (cus %d, per_cu %d)\n", grid, cus, per_cu);
    }
    if (grid < 0) return;
    Args a{};
    for (int i = 0; i < 25; ++i) a.in[i] = (const float*)d_in[i];
    a.out = (float*)d_out; a.ws = (unsigned char*)d_ws;
    void* kargs[] = {&a};
    hipError_t e = hipLaunchCooperativeKernel((const void*)fwd_megakernel, dim3(grid), dim3(512), kargs, LDS_BYTES, stream);
    if (e != hipSuccess) fprintf(stderr, "kernel_launch: cooperative launch failed: %s (grid %d)\n", hipGetErrorString(e), grid);
}
```
